# Optimizing an MI355X kernel written in HIP

```python
import math
import jax, jax.numpy as jnp
from jax import lax
import numpy as np

D_MODEL = 1024
BATCH = 16
SEQ = 2048
DEPTH = 4

GRID_W = 64
NA_HEAD_DIM = 64
NA_HEADS = (D_MODEL // 2) // NA_HEAD_DIM
NA_WIN_H_MAX = 8
NA_WIN_W = 16
NA_QBLOCK_W = 16
NA_KBLOCK_W = NA_QBLOCK_W + NA_WIN_W
ML_HEADS = 4
ML_HEAD_DIM = (D_MODEL // 2) // ML_HEADS
ML_CHUNK = 64
D_A = NA_HEADS * NA_HEAD_DIM
D_B = ML_HEADS * ML_HEAD_DIM
D_MIX = D_A + D_B
AB_IN = 3 * D_A + 4 * D_B + 4 * ML_HEADS
CONV_W = 3
D_FF = ((8 * D_MODEL // 3 + 255) // 256) * 256
N_EVEN = (DEPTH + 1) // 2
N_ODD = DEPTH // 2
DEEPNORM_ALPHA = (2 * DEPTH) ** 0.25
DEEPNORM_BETA = (8 * DEPTH) ** -0.25
LN_EPS = 1e-5

kernel_name = "hybrid_natten_mlstm_shortconv_macaron"


def layer_norm(x, g, b):
    xf = x.astype(jnp.float32)
    mu = jnp.mean(xf, axis=-1, keepdims=True)
    var = jnp.mean(jnp.square(xf - mu), axis=-1, keepdims=True)
    y = (xf - mu) * lax.rsqrt(var + LN_EPS)
    return (y * g.astype(jnp.float32) + b.astype(jnp.float32)).astype(x.dtype)


def swiglu_ffn(x, w_in, w_out):
    g, u = jnp.split(x @ w_in, 2, axis=-1)
    return (jax.nn.silu(g) * u) @ w_out


def neighbourhood_attention(q, k, v, rpb):
    B, S, H, dh = q.shape
    rows = S // GRID_W
    wh = min(NA_WIN_H_MAX, rows)
    nqb = GRID_W // NA_QBLOCK_W
    r = np.arange(rows)
    row_start = np.clip(r - wh // 2, 0, rows - wh)
    row_idx = row_start[:, None] + np.arange(wh)[None, :]
    c = np.arange(GRID_W)
    col_start = np.clip(c - NA_WIN_W // 2, 0, GRID_W - NA_WIN_W)
    kb_start = np.clip(np.arange(nqb) * NA_QBLOCK_W - NA_WIN_W // 2, 0, GRID_W - NA_KBLOCK_W)
    col_idx = kb_start[:, None] + np.arange(NA_KBLOCK_W)[None, :]
    qcol = c.reshape(nqb, NA_QBLOCK_W)
    qstart = col_start.reshape(nqb, NA_QBLOCK_W)[..., None]
    kcol = col_idx[:, None, :]
    col_ok = (kcol >= qstart) & (kcol < qstart + NA_WIN_W)
    dr = row_idx - r[:, None] + (NA_WIN_H_MAX - 1)
    dc = np.clip(kcol - qcol[..., None] + (NA_WIN_W - 1), 0, 2 * NA_WIN_W - 2)
    bias = rpb[:, dr[:, None, None, :, None], dc[None, :, :, None, :]]

    qg = q.reshape(B, rows, nqb, NA_QBLOCK_W, H, dh).transpose(0, 4, 1, 2, 3, 5)
    kg = k.reshape(B, rows, GRID_W, H, dh).transpose(0, 3, 1, 2, 4)
    vg = v.reshape(B, rows, GRID_W, H, dh).transpose(0, 3, 1, 2, 4)
    ri = row_idx[:, :, None, None]
    ci = col_idx[None, None, :, :]
    kb = kg[:, :, ri, ci]
    vb = vg[:, :, ri, ci]
    s = jnp.einsum('bhrjqd,bhrijkd->bhrjqik', qg, kb).astype(jnp.float32)
    s = s + bias.astype(jnp.float32)[None]
    s = jnp.where(col_ok[:, :, None, :], s, -jnp.inf)
    p = jax.nn.softmax(s, axis=(-2, -1)).astype(v.dtype)
    o = jnp.einsum('bhrjqik,bhrijkd->bhrjqd', p, vb)
    return o.transpose(0, 2, 3, 4, 1, 5).reshape(B, S, H * dh)


def mlstm_chunkwise(q, k, v, i_pre, f_pre):
    B, H, S, d = q.shape
    L = ML_CHUNK
    nc = S // L
    logf = jax.nn.log_sigmoid(f_pre)

    def to_chunks(a):
        return jnp.moveaxis(a.reshape(B, H, nc, L, *a.shape[3:]), 2, 0)

    xs = (to_chunks(q), to_chunks(k), to_chunks(v), to_chunks(i_pre), to_chunks(logf))
    lower = jnp.asarray(np.tril(np.ones((L, L), dtype=bool)))

    def step(carry, xs_c):
        C, n, m = carry
        qx, kx, vx, ix, fx = xs_c
        b = jnp.cumsum(fx, axis=-1)
        g = b[..., -1]
        dmat = jnp.where(lower, b[..., :, None] - b[..., None, :] + ix[..., None, :], -jnp.inf)
        inter = b + m[..., None]
        m_t = jnp.maximum(inter, jnp.max(dmat, axis=-1))
        w = jnp.exp(dmat - m_t[..., None])
        s_inter = jnp.exp(inter - m_t)
        qk = jnp.einsum('bhtd,bhsd->bhts', qx, kx) * w
        num = jnp.einsum('bhts,bhse->bhte', qk, vx) + s_inter[..., None] * jnp.einsum('bhtd,bhde->bhte', qx, C)
        den = jnp.sum(qk, axis=-1) + s_inter * jnp.einsum('bhtd,bhd->bht', qx, n)
        h = num / jnp.maximum(jnp.abs(den), jnp.exp(-m_t))[..., None]
        a = g[..., None] - b + ix
        m_new = jnp.maximum(g + m, jnp.max(a, axis=-1))
        decay = jnp.exp(g + m - m_new)
        wa = jnp.exp(a - m_new[..., None])
        C_new = decay[..., None, None] * C + jnp.einsum('bhs,bhsd,bhse->bhde', wa, kx, vx)
        n_new = decay[..., None] * n + jnp.einsum('bhs,bhsd->bhd', wa, kx)
        return (C_new, n_new, m_new), h

    init = (jnp.zeros((B, H, d, d), jnp.float32), jnp.zeros((B, H, d), jnp.float32),
            jnp.zeros((B, H), jnp.float32))
    _, hs = lax.scan(step, init, xs)
    return jnp.moveaxis(hs, 0, 2).reshape(B, H, S, d)


def na_mlstm_mixer(x, w_in, gate_b, rpb, gn_g, w_out):
    B, S, _ = x.shape
    cuts = [D_A, 2 * D_A, 3 * D_A, 3 * D_A + D_B, 3 * D_A + 2 * D_B, 3 * D_A + 3 * D_B, 3 * D_A + 4 * D_B]
    qa, ka, va, qb, kb, vb, ob, gates = jnp.split(x @ w_in, cuts, axis=-1)
    ha = lambda t: t.reshape(B, S, NA_HEADS, NA_HEAD_DIM)
    ya = neighbourhood_attention(ha(qa) * (NA_HEAD_DIM ** -0.5), ha(ka), ha(va), rpb)
    hb = lambda t: t.reshape(B, S, ML_HEADS, ML_HEAD_DIM).transpose(0, 2, 1, 3).astype(jnp.float32)
    q_m, k_m, v_m = hb(qb), hb(kb) * (ML_HEAD_DIM ** -0.5), hb(vb)
    g = gates.astype(jnp.float32).reshape(B, S, 4, ML_HEADS) + gate_b.astype(jnp.float32)
    i_f, f_f, i_b, f_b = g.transpose(2, 0, 3, 1)
    h_fwd = mlstm_chunkwise(q_m, k_m, v_m, i_f, f_f)
    flip = lambda t: jnp.flip(t, axis=2)
    h_bwd = flip(mlstm_chunkwise(flip(q_m), flip(k_m), flip(v_m), flip(i_b), flip(f_b)))
    h = h_fwd + h_bwd
    mu = jnp.mean(h, axis=-1, keepdims=True)
    var = jnp.mean(jnp.square(h - mu), axis=-1, keepdims=True)
    hn = ((h - mu) * lax.rsqrt(var + LN_EPS)).transpose(0, 2, 1, 3).reshape(B, S, D_B)
    yb = (jax.nn.sigmoid(ob.astype(jnp.float32)) * hn * gn_g.astype(jnp.float32)).astype(x.dtype)
    return jnp.concatenate([ya, yb], axis=-1) @ w_out


def short_conv_mixer(x, w_in, conv_w, conv_b, w_out):
    bg, cg, h = jnp.split(x @ w_in, 3, axis=-1)
    u = cg * h
    y = lax.conv_general_dilated(u, conv_w[:, None, :].astype(u.dtype), window_strides=(1,),
                                 padding=((CONV_W // 2, CONV_W // 2),),
                                 dimension_numbers=('NWC', 'WIO', 'NWC'),
                                 feature_group_count=D_MODEL) + conv_b
    return (bg * y) @ w_out


def setup_inputs(seed: int = 0) -> dict:
    key = jax.random.key(seed)
    ks = jax.random.split(key, 16)
    nrm = jax.random.normal
    x = nrm(ks[0], (BATCH, SEQ, D_MODEL), jnp.float32)
    ln_g = 1.0 + 0.02 * nrm(ks[1], (DEPTH, 3, D_MODEL), jnp.float32)
    ln_b = 0.02 * nrm(ks[2], (DEPTH, 3, D_MODEL), jnp.float32)
    ffn_w_in = nrm(ks[3], (DEPTH, 2, D_MODEL, 2 * D_FF), jnp.float32) * D_MODEL ** -0.5
    ffn_w_out = nrm(ks[4], (DEPTH, 2, D_FF, D_MODEL), jnp.float32) * (D_FF ** -0.5 * DEEPNORM_BETA)
    ab_w_in = nrm(ks[5], (N_EVEN, D_MODEL, AB_IN), jnp.float32) * D_MODEL ** -0.5
    f_bias = jnp.linspace(3.0, 6.0, ML_HEADS, dtype=jnp.float32)
    zero_h = jnp.zeros((ML_HEADS,), jnp.float32)
    ab_gate_b = jnp.stack([zero_h, f_bias, zero_h, f_bias])[None] + 0.1 * nrm(ks[6], (N_EVEN, 4, ML_HEADS), jnp.float32)
    na_rpb = 0.02 * nrm(ks[7], (N_EVEN, NA_HEADS, 2 * NA_WIN_H_MAX - 1, 2 * NA_WIN_W - 1), jnp.float32)
    ml_gn_g = 1.0 + 0.02 * nrm(ks[8], (N_EVEN, D_B), jnp.float32)
    ab_w_out = nrm(ks[9], (N_EVEN, D_MIX, D_MODEL), jnp.float32) * (D_MIX ** -0.5 * DEEPNORM_BETA)
    sc_w_in = nrm(ks[10], (N_ODD, D_MODEL, 3 * D_MODEL), jnp.float32) * D_MODEL ** -0.5
    sc_conv_w = nrm(ks[11], (N_ODD, CONV_W, D_MODEL), jnp.float32) * CONV_W ** -0.5
    sc_conv_b = 0.02 * nrm(ks[12], (N_ODD, D_MODEL), jnp.float32)
    sc_w_out = nrm(ks[13], (N_ODD, D_MODEL, D_MODEL), jnp.float32) * (D_MODEL ** -0.5 * DEEPNORM_BETA)
    return {"x": x, "ln_g": ln_g, "ln_b": ln_b, "ffn_w_in": ffn_w_in, "ffn_w_out": ffn_w_out,
            "ab_w_in": ab_w_in, "ab_gate_b": ab_gate_b, "na_rpb": na_rpb, "ml_gn_g": ml_gn_g,
            "ab_w_out": ab_w_out, "sc_w_in": sc_w_in, "sc_conv_w": sc_conv_w,
            "sc_conv_b": sc_conv_b, "sc_w_out": sc_w_out}


def reference(x, ln_g, ln_b, ffn_w_in, ffn_w_out, ab_w_in, ab_gate_b, na_rpb, ml_gn_g,
              ab_w_out, sc_w_in, sc_conv_w, sc_conv_b, sc_w_out):
    a = DEEPNORM_ALPHA
    for layer in range(DEPTH):
        x = layer_norm(a * x + 0.5 * swiglu_ffn(x, ffn_w_in[layer, 0], ffn_w_out[layer, 0]),
                       ln_g[layer, 0], ln_b[layer, 0])
        if layer % 2 == 0:
            e = layer // 2
            mix = na_mlstm_mixer(x, ab_w_in[e], ab_gate_b[e], na_rpb[e], ml_gn_g[e], ab_w_out[e])
        else:
            o = layer // 2
            mix = short_conv_mixer(x, sc_w_in[o], sc_conv_w[o], sc_conv_b[o], sc_w_out[o])
        x = layer_norm(a * x + mix, ln_g[layer, 1], ln_b[layer, 1])
        x = layer_norm(a * x + 0.5 * swiglu_ffn(x, ffn_w_in[layer, 1], ffn_w_out[layer, 1]),
                       ln_g[layer, 2], ln_b[layer, 2])
    return x
```

```cpp
#include <hip/hip_runtime.h>
#include <hip/hip_cooperative_groups.h>
#include <cstdio>
#include <cstdint>
#include <cmath>
namespace cg = cooperative_groups;
namespace pg8 {
#define PG8_LAS __attribute__((address_space(3)))
typedef unsigned short bf16_t;
typedef short bf16x8 __attribute__((ext_vector_type(8)));
typedef float f32x4 __attribute__((ext_vector_type(4)));
typedef unsigned u32x4 __attribute__((ext_vector_type(4)));
constexpr int BM = 256, BK = 64, HALF = 128, HTB = HALF * BK * 2  , STAGE_BYTES = 8 * HTB, NXCD = 8, WGM = 8;

__host__ __device__ __forceinline__ int lds_byte(int r, int c) { const int st = (r >> 4) * 2 + (c >> 5), rr = r & 15, cc = c & 31, ob = rr * 64 + cc * 2; return st * 1024 + (ob ^ (((ob >> 9) & 1) << 5)); }
__host__ __device__ __forceinline__ void stage_rc(int b, int& R, int& C) { const int st = b / 1024, sb = b % 1024, swz = sb ^ (((sb >> 9) & 1) << 5); R = (st >> 1) * 16 + swz / 64; C = (st & 1) * 32 + (swz % 64) / 2; }
__host__ __device__ __forceinline__ int perm32(int rho) { const int n = rho >> 4, i = rho & 15; return 8 * (i >> 2) + 4 * n + (i & 3); }

struct Unit { int pm, pn; };
struct Gemm { const bf16_t* A; const bf16_t* Bt; int M, N, K; };

struct StaticOrder {
    int nM, nN, nwg, G, c;
    __host__ __device__ void init(int M, int N, int G_, int c_) { nM = M / BM; nN = N / BM; nwg = nM * nN; G = G_; c = c_; }
    __host__ __device__ bool next(int i, Unit& u) const {
        const long L = (long)i * G + c; if (L >= nwg) return false;
        int wgid = (int)L; { const int q = nwg / NXCD, r = nwg % NXCD, xcd = wgid % NXCD, off = wgid / NXCD; wgid = (xcd < r ? xcd * (q + 1) : r * (q + 1) + (xcd - r) * q) + off; }
        const int nig = WGM * nN, gid = wgid / nig, fm = gid * WGM, gsz = (nM - fm) < WGM ? (nM - fm) : WGM;
        u.pm = fm + ((wgid % nig) % gsz); u.pn = (wgid % nig) / gsz; return true;
    }
    __device__ __forceinline__ void a_ready(const Unit&) const {}
    __device__ __forceinline__ void done(const Unit&) const {}
};

typedef float f32x2_cv __attribute__((ext_vector_type(2))); typedef __bf16 bf16x2_cv __attribute__((ext_vector_type(2)));
__device__ __forceinline__ unsigned cvt_pk_bf16(float lo, float hi) { const f32x2_cv v = {lo, hi}; const bf16x2_cv b = __builtin_convertvector(v, bf16x2_cv); return __builtin_bit_cast(unsigned, b); }
__device__ __forceinline__ float silu_f(float x) { return x * __builtin_amdgcn_rcpf(1.0f + __expf(-x)); }
struct EpiSwiGLU {
    static constexpr bool PERM = true, AFTER_DRAIN = false;
    bf16_t* H; int ldh;
    __device__ __forceinline__ void operator()(const f32x4 (&acc)[2][2][4][2], const Unit& u, int wr, int wc, int fr, int fq) const {
        const int row0 = u.pm * BM + wr * 64 + fr; const int col0 = u.pn * HALF + wc * 32 + 8 * fq;
#pragma unroll
        for (int ai = 0; ai < 2; ++ai)
#pragma unroll
            for (int m = 0; m < 4; ++m) {
                bf16_t* p = H + (size_t)(row0 + ai * HALF + m * 16) * ldh + col0;
                const f32x4 g0 = acc[ai][0][m][0], g1 = acc[ai][0][m][1], u0 = acc[ai][1][m][0], u1 = acc[ai][1][m][1];
                u32x4 w;
                w.x = cvt_pk_bf16(silu_f(g0[0]) * u0[0], silu_f(g0[1]) * u0[1]);
                w.y = cvt_pk_bf16(silu_f(g0[2]) * u0[2], silu_f(g0[3]) * u0[3]);
                w.z = cvt_pk_bf16(silu_f(g1[0]) * u1[0], silu_f(g1[1]) * u1[1]);
                w.w = cvt_pk_bf16(silu_f(g1[2]) * u1[2], silu_f(g1[3]) * u1[3]);
                *(u32x4*)p = w;
            }
    }
};
struct EpiResid {
    static constexpr bool PERM = false, AFTER_DRAIN = false;
    float* Y; int ldc; float alpha, scale;
    __device__ __forceinline__ void operator()(const f32x4 (&acc)[2][2][4][2], const Unit& u, int wr, int wc, int fr, int fq) const {
        const int row0 = u.pm * BM + wr * 64 + fr; const int col0 = u.pn * BM + wc * 32 + 4 * fq;
#pragma unroll
        for (int ai = 0; ai < 2; ++ai)
#pragma unroll
            for (int m = 0; m < 4; ++m) {
                float* rp = Y + (size_t)(row0 + ai * HALF + m * 16) * ldc + col0;
#pragma unroll
                for (int bj = 0; bj < 2; ++bj)
#pragma unroll
                    for (int n = 0; n < 2; ++n) { f32x4* p = (f32x4*)(rp + bj * HALF + n * 16); const f32x4 x = *p; *p = x * alpha + acc[ai][bj][m][n] * scale; }
                asm volatile("" ::: "memory");
            }
    }
};
struct EpiAB {
    static constexpr bool PERM = true, AFTER_DRAIN = false;
    bf16_t* O; int ldc; float* gates; int gate_tile;
    __device__ __forceinline__ void operator()(const f32x4 (&acc)[2][2][4][2], const Unit& u, int wr, int wc, int fr, int fq) const {
        const int row0 = u.pm * BM + wr * 64 + fr;
        if (u.pn == gate_tile) {
            if (wc == 0 && fq < 2) {
#pragma unroll
                for (int ai = 0; ai < 2; ++ai)
#pragma unroll
                    for (int m = 0; m < 4; ++m) { float* gp = gates + (size_t)(row0 + ai * HALF + m * 16) * 16 + 8 * fq; *(f32x4*)gp = acc[ai][0][m][0]; *(f32x4*)(gp + 4) = acc[ai][0][m][1]; }
            }
            return;
        }
        const int col0 = u.pn * BM + wc * 32 + 8 * fq;
#pragma unroll
        for (int ai = 0; ai < 2; ++ai)
#pragma unroll
            for (int m = 0; m < 4; ++m) { bf16_t* rowp = O + (size_t)(row0 + ai * HALF + m * 16) * ldc + col0;
#pragma unroll
                for (int bj = 0; bj < 2; ++bj) { const f32x4 v0 = acc[ai][bj][m][0], v1 = acc[ai][bj][m][1];
                    u32x4 w; w.x = cvt_pk_bf16(v0[0], v0[1]); w.y = cvt_pk_bf16(v0[2], v0[3]); w.z = cvt_pk_bf16(v1[0], v1[1]); w.w = cvt_pk_bf16(v1[2], v1[3]);
                    *(u32x4*)(rowp + bj * HALF) = w; } }
    }
};
struct EpiConvIn {
    static constexpr bool PERM = true, AFTER_DRAIN = false;
    bf16_t* BG; bf16_t* U;
    __device__ __forceinline__ void operator()(const f32x4 (&acc)[2][2][4][2], const Unit& u, int wr, int wc, int fr, int fq) const {
        const int row0 = u.pm * BM + wr * 64 + fr;
        if (u.pn < 4) {
            const int col0 = u.pn * BM + wc * 32 + 8 * fq;
#pragma unroll
            for (int ai = 0; ai < 2; ++ai)
#pragma unroll
                for (int m = 0; m < 4; ++m) { bf16_t* rowp = BG + (size_t)(row0 + ai * HALF + m * 16) * 1024 + col0;
#pragma unroll
                    for (int bj = 0; bj < 2; ++bj) { const f32x4 v0 = acc[ai][bj][m][0], v1 = acc[ai][bj][m][1];
                        u32x4 w; w.x = cvt_pk_bf16(v0[0], v0[1]); w.y = cvt_pk_bf16(v0[2], v0[3]); w.z = cvt_pk_bf16(v1[0], v1[1]); w.w = cvt_pk_bf16(v1[2], v1[3]);
                        *(u32x4*)(rowp + bj * HALF) = w; } }
        } else {
            const int col0 = (u.pn - 4) * HALF + wc * 32 + 8 * fq;
#pragma unroll
            for (int ai = 0; ai < 2; ++ai)
#pragma unroll
                for (int m = 0; m < 4; ++m) { bf16_t* p = U + (size_t)(row0 + ai * HALF + m * 16) * 1024 + col0;
                    const f32x4 v0 = acc[ai][0][m][0] * acc[ai][1][m][0], v1 = acc[ai][0][m][1] * acc[ai][1][m][1];
                    u32x4 w; w.x = cvt_pk_bf16(v0[0], v0[1]); w.y = cvt_pk_bf16(v0[2], v0[3]); w.z = cvt_pk_bf16(v1[0], v1[1]); w.w = cvt_pk_bf16(v1[2], v1[3]);
                    *(u32x4*)p = w; }
        }
    }
};

template <class Epi, class Sched, bool ALIGN_EPI = false, bool SP2 = false>
__device__ __forceinline__ void gemm_phase(PG8_LAS unsigned char* lds, const Gemm g, const Sched& S, const Epi& E) {
    int tid = threadIdx.x; asm volatile("" : "+v"(tid)); const int wid = __builtin_amdgcn_readfirstlane(tid >> 6), lane = tid & 63, wr = wid >> 2, wc = wid & 3, fr = lane & 15, fq = lane >> 4;
    const int K = g.K, nt = K / BK;
    unsigned voffA[2], voffB[2];
#pragma unroll
    for (int i = 0; i < 2; ++i) { int R, C; stage_rc(tid * 16 + i * 8192, R, C); const int Rb = Epi::PERM ? ((R & ~31) + perm32(R & 31)) : R;
        voffA[i] = (unsigned)(R * K + C) * 2u; voffB[i] = (unsigned)(Rb * K + C) * 2u; }
    const size_t kstep = (size_t)(BK * 2);
    const size_t hstep = (size_t)HALF * K * 2;
    const size_t tstep = 2 * hstep;
    const unsigned ldsw = (unsigned)wid * 1024u;
    const int aoff = lds_byte(wr * 64 + fr, fq * 8), boff = lds_byte(wc * 32 + fr, fq * 8);
#define PG8_SA(b, h) (((b) * 2 + (h)) * HTB)
#define PG8_SB(b, h) ((4 + (b) * 2 + (h)) * HTB)
#define PG8_STAGE(bufoff, gbase, voff) do { _Pragma("unroll") for (int _i = 0; _i < 2; ++_i) \
        __builtin_amdgcn_global_load_lds((const unsigned*)((const char*)(gbase) + (voff)[_i]), (PG8_LAS unsigned*)(lds + (bufoff) + ldsw + _i * 8192), 16, 0, 0); } while (0)
#define PG8_LDA(dst, b, h) do { _Pragma("unroll") for (int m = 0; m < 4; ++m) _Pragma("unroll") for (int k = 0; k < 2; ++k) dst[m][k] = *(const PG8_LAS bf16x8*)(lds + PG8_SA(b, h) + aoff + m * 2048 + k * 1024); } while (0)
#define PG8_LDB(dst, b, h) do { _Pragma("unroll") for (int n = 0; n < 2; ++n) _Pragma("unroll") for (int k = 0; k < 2; ++k) dst[n][k] = *(const PG8_LAS bf16x8*)(lds + PG8_SB(b, h) + boff + n * 2048 + k * 1024); } while (0)
#define PG8_MMA(ai, bj, At, Bt) do { __builtin_amdgcn_s_setprio(1); _Pragma("unroll") for (int m = 0; m < 4; ++m) _Pragma("unroll") for (int n = 0; n < 2; ++n) _Pragma("unroll") for (int k = 0; k < 2; ++k) \
        acc[ai][bj][m][n] = __builtin_amdgcn_mfma_f32_16x16x32_bf16(Bt[n][k], At[m][k], acc[ai][bj][m][n], 0, 0, 0); __builtin_amdgcn_s_setprio(0); } while (0)
#define PG8_WAIT_V(n) asm volatile("s_waitcnt vmcnt(" #n ")" ::: "memory")
#define PG8_WAIT_L(n) asm volatile("s_waitcnt lgkmcnt(" #n ")" ::: "memory")
#define PG8_BAR __builtin_amdgcn_s_barrier()
#define PG8_SCHED __builtin_amdgcn_sched_barrier(0)
    Unit cur, nxt; int ui = 0;
    if (!S.next(0, cur)) return;
    f32x4 acc[2][2][4][2];
#pragma unroll
    for (int a = 0; a < 2; ++a)
#pragma unroll
        for (int b = 0; b < 2; ++b)
#pragma unroll
            for (int m = 0; m < 4; ++m)
#pragma unroll
                for (int n = 0; n < 2; ++n) acc[a][b][m][n] = (f32x4){0.f, 0.f, 0.f, 0.f};
    bf16x8 At[4][2], B0[2][2], B1[2][2];
    const char* cA = (const char*)g.A + (size_t)cur.pm * tstep; const char* cB = (const char*)g.Bt + (size_t)cur.pn * tstep;
    S.a_ready(cur);
    if constexpr (SP2) {
        PG8_STAGE(PG8_SB(0, 0), cB, voffB); PG8_STAGE(PG8_SB(0, 1), cB + hstep, voffB); PG8_STAGE(PG8_SA(0, 0), cA, voffA); PG8_STAGE(PG8_SA(0, 1), cA + hstep, voffA);
        if (wr == 1) PG8_BAR;
        PG8_WAIT_V(2); PG8_BAR;
        PG8_STAGE(PG8_SB(1, 0), cB + kstep, voffB); PG8_STAGE(PG8_SA(1, 0), cA + kstep, voffA); PG8_STAGE(PG8_SB(1, 1), cB + hstep + kstep, voffB);
        PG8_WAIT_V(6); PG8_BAR;
    } else {
        PG8_STAGE(PG8_SB(0, 0), cB, voffB); PG8_STAGE(PG8_SA(0, 0), cA, voffA); PG8_STAGE(PG8_SB(0, 1), cB + hstep, voffB); PG8_STAGE(PG8_SA(0, 1), cA + hstep, voffA);
        if (wr == 1) PG8_BAR;
        PG8_WAIT_V(4); PG8_BAR;
        PG8_STAGE(PG8_SB(1, 0), cB + kstep, voffB); PG8_STAGE(PG8_SA(1, 0), cA + kstep, voffA); PG8_STAGE(PG8_SB(1, 1), cB + hstep + kstep, voffB);
        PG8_WAIT_V(6); PG8_BAR;
    }
    for (;;) {
        const bool has_next = S.next(ui + 1, nxt);
        const char* nA = has_next ? (const char*)g.A + (size_t)nxt.pm * tstep : cA; const char* nB = has_next ? (const char*)g.Bt + (size_t)nxt.pn * tstep : cB;
        for (int t = 0; t < nt; t += 2) {
            const bool last = (t == nt - 2);
            const char* a1 = cA + (size_t)(t + 1) * kstep;
            const char* a2 = last ? nA : cA + (size_t)(t + 2) * kstep; const char* b2 = last ? nB : cB + (size_t)(t + 2) * kstep;
            const char* a3 = a2 + kstep; const char* b3 = b2 + kstep;
            if (last && has_next) S.a_ready(nxt);
            if constexpr (SP2) {
            PG8_LDB(B0, 0, 0); PG8_LDB(B1, 0, 1); PG8_SCHED; PG8_LDA(At, 0, 0); PG8_STAGE(PG8_SA(1, 1), a1 + hstep, voffA);
            PG8_WAIT_V(8); PG8_WAIT_L(0); PG8_BAR; PG8_MMA(0, 0, At, B0); PG8_MMA(0, 1, At, B1); PG8_BAR; PG8_SCHED;
            PG8_LDA(At, 0, 1); PG8_STAGE(PG8_SB(0, 0), b2, voffB); PG8_STAGE(PG8_SB(0, 1), b2 + hstep, voffB); PG8_STAGE(PG8_SA(0, 0), a2, voffA);
            PG8_WAIT_V(8); PG8_WAIT_L(0); PG8_BAR; PG8_MMA(1, 0, At, B0); PG8_MMA(1, 1, At, B1); PG8_BAR; PG8_SCHED;
            PG8_LDB(B0, 1, 0); PG8_LDB(B1, 1, 1); PG8_SCHED; PG8_LDA(At, 1, 0); PG8_STAGE(PG8_SA(0, 1), a2 + hstep, voffA);
            PG8_WAIT_V(8); PG8_WAIT_L(0); PG8_BAR; PG8_MMA(0, 0, At, B0); PG8_MMA(0, 1, At, B1); PG8_BAR; PG8_SCHED;
            PG8_LDA(At, 1, 1); PG8_STAGE(PG8_SB(1, 0), b3, voffB); PG8_STAGE(PG8_SB(1, 1), b3 + hstep, voffB); PG8_STAGE(PG8_SA(1, 0), a3, voffA);
            PG8_WAIT_V(8); PG8_WAIT_L(0); PG8_BAR; PG8_MMA(1, 0, At, B0); PG8_MMA(1, 1, At, B1); PG8_BAR; PG8_SCHED;
            } else {
            PG8_LDB(B0, 0, 0); PG8_SCHED; PG8_LDA(At, 0, 0); PG8_STAGE(PG8_SA(1, 1), a1 + hstep, voffA);
            PG8_WAIT_L(8); PG8_BAR; PG8_WAIT_L(0); PG8_MMA(0, 0, At, B0); PG8_BAR; PG8_SCHED;
            PG8_LDB(B1, 0, 1); PG8_STAGE(PG8_SB(0, 0), b2, voffB);
            PG8_BAR; PG8_WAIT_L(0); PG8_MMA(0, 1, At, B1); PG8_BAR;
            PG8_LDA(At, 0, 1); PG8_STAGE(PG8_SA(0, 0), a2, voffA);
            PG8_BAR; PG8_WAIT_L(0); PG8_MMA(1, 0, At, B0); PG8_BAR; PG8_SCHED;
            PG8_STAGE(PG8_SB(0, 1), b2 + hstep, voffB);
            PG8_WAIT_V(6); PG8_BAR; PG8_MMA(1, 1, At, B1); PG8_BAR;
            PG8_LDB(B0, 1, 0); PG8_SCHED; PG8_LDA(At, 1, 0); PG8_STAGE(PG8_SA(0, 1), a2 + hstep, voffA);
            PG8_WAIT_L(8); PG8_BAR; PG8_WAIT_L(0); PG8_MMA(0, 0, At, B0); PG8_BAR; PG8_SCHED;
            PG8_LDB(B1, 1, 1); PG8_STAGE(PG8_SB(1, 0), b3, voffB);
            PG8_BAR; PG8_WAIT_L(0); PG8_MMA(0, 1, At, B1); PG8_BAR;
            PG8_LDA(At, 1, 1); PG8_STAGE(PG8_SA(1, 0), a3, voffA);
            PG8_BAR; PG8_WAIT_L(0); PG8_MMA(1, 0, At, B0); PG8_BAR; PG8_SCHED;
            PG8_STAGE(PG8_SB(1, 1), b3 + hstep, voffB);
            PG8_WAIT_V(6); PG8_BAR; PG8_MMA(1, 1, At, B1); PG8_BAR;
            }
        }
        if constexpr (ALIGN_EPI) { if (wr == 0) PG8_BAR; }
        if constexpr (!Epi::AFTER_DRAIN) { E(acc, cur, wr, wc, fr, fq); S.done(cur); }
        if (!has_next) break;
#pragma unroll
        for (int a = 0; a < 2; ++a)
#pragma unroll
            for (int b = 0; b < 2; ++b)
#pragma unroll
                for (int m = 0; m < 4; ++m)
#pragma unroll
                    for (int n = 0; n < 2; ++n) acc[a][b][m][n] = (f32x4){0.f, 0.f, 0.f, 0.f};
        cur = nxt; cA = nA; cB = nB; ++ui;
        if constexpr (ALIGN_EPI) { if (wr == 1) PG8_BAR; }
    }
    PG8_WAIT_V(0);
    if constexpr (!ALIGN_EPI) { if (wr == 0) PG8_BAR; }
    PG8_BAR;
    if constexpr (Epi::AFTER_DRAIN) { E.fused(acc, cur, wr, wc, fr, fq, lds, wid, lane); S.done(cur); }
#undef PG8_SA
#undef PG8_SB
#undef PG8_STAGE
#undef PG8_LDA
#undef PG8_LDB
#undef PG8_MMA
#undef PG8_WAIT_V
#undef PG8_WAIT_L
#undef PG8_BAR
#undef PG8_SCHED
}
}

constexpr int DM = 1024, NB = 16, SEQ = 2048, DEPTH = 4, M = NB * SEQ, DFF = 2816, NFF = 2 * DFF;
constexpr int AB_N = 3600, AB_NP = 3840, SC_N = 3072;
constexpr float LN_EPS = 1e-5f;
constexpr float DN_ALPHA = 1.681792830507429f;
constexpr int NWAVES = 8, NT = NWAVES * 64;
constexpr int LDS_BYTES = 147456;
#ifndef M3_SHIFT
#define M3_SHIFT 0
#endif
#ifndef N_SL_DEF
#define N_SL_DEF 12
#endif
constexpr int N_SL = N_SL_DEF;

constexpr size_t MiB = 1u << 20;
constexpr size_t SZ_WFI = (size_t)NFF * DM * 2, SZ_WFO = (size_t)DM * DFF * 2, SZ_WAI = (size_t)AB_NP * DM * 2, SZ_WSQ = (size_t)DM * DM * 2, SZ_WSI = (size_t)SC_N * DM * 2;
constexpr size_t WS_WFI = 1 * MiB;
constexpr size_t WS_WFO = WS_WFI + 8 * SZ_WFI;
constexpr size_t WS_WAI = WS_WFO + 8 * SZ_WFO;
constexpr size_t WS_WAO = WS_WAI + 2 * SZ_WAI;
constexpr size_t WS_WSI = WS_WAO + 2 * SZ_WSQ;
constexpr size_t WS_WSO = WS_WSI + 2 * SZ_WSI;
constexpr size_t WS_XN = WS_WSO + 2 * SZ_WSQ;
constexpr size_t WS_MIX = WS_XN + (size_t)M * DM * 2;
constexpr size_t WS_BIG = WS_MIX + (size_t)M * DM * 2;
constexpr size_t WS_GATES = WS_BIG + (size_t)M * AB_NP * 2;
constexpr size_t WS_DC = WS_GATES + (size_t)M * 16 * 4;
constexpr size_t WS_DN = WS_DC + (size_t)4096 * 16384 * 2;
constexpr size_t WS_SC = WS_DN + (size_t)4096 * 128 * 4;
constexpr size_t WS_MS = WS_SC + (size_t)4096 * 32 * 4;
constexpr size_t WS_END = WS_MS + (size_t)4096 * 4;
static_assert(WS_END <= (size_t)738197504, "workspace map exceeds the guaranteed size");
static_assert(WS_WFI % 256 == 0 && WS_XN % 256 == 0 && WS_BIG % 256 == 0 && WS_DC % 256 == 0, "alignment");

#define LAS __attribute__((address_space(3)))
typedef unsigned short bf16;
typedef unsigned v4u __attribute__((ext_vector_type(4)));
typedef unsigned v2u __attribute__((ext_vector_type(2)));
typedef float f32x4 __attribute__((ext_vector_type(4)));
typedef short bf16x8 __attribute__((ext_vector_type(8)));
#define MFMA16(a, b, c) __builtin_amdgcn_mfma_f32_16x16x32_bf16((a), (b), (c), 0, 0, 0)

__device__ __forceinline__ float bf2f(unsigned short h) { return __builtin_bit_cast(float, (unsigned)h << 16); }
__device__ __forceinline__ float bflo(unsigned w) { return __builtin_bit_cast(float, w << 16); }
__device__ __forceinline__ float bfhi(unsigned w) { return __builtin_bit_cast(float, w & 0xffff0000u); }
__device__ __forceinline__ unsigned pk2(float lo, float hi) { return pg8::cvt_pk_bf16(lo, hi); }
__device__ __forceinline__ float wave_sum(float v) {
#pragma unroll
    for (int o = 1; o < 64; o <<= 1) v += __shfl_xor(v, o);
    return v;
}
__device__ __forceinline__ float wave_max(float v) {
#pragma unroll
    for (int o = 1; o < 64; o <<= 1) v = fmaxf(v, __shfl_xor(v, o));
    return v;
}
__device__ __forceinline__ float scan_sum(float x, int lane, int rev) {
#pragma unroll
    for (int o = 1; o < 64; o <<= 1) { const float up = __shfl_up(x, o), dn = __shfl_down(x, o); const bool ok = rev ? (lane + o < 64) : (lane >= o); const float t = rev ? dn : up; if (ok) x += t; }
    return x;
}
__device__ __forceinline__ float scan_max(float x, int lane, int rev) {
#pragma unroll
    for (int o = 1; o < 64; o <<= 1) { const float up = __shfl_up(x, o), dn = __shfl_down(x, o); const bool ok = rev ? (lane + o < 64) : (lane >= o); const float t = rev ? dn : up; if (ok) x = fmaxf(x, t); }
    return x;
}
__device__ __forceinline__ float log_sigmoid(float x) { return fminf(x, 0.f) - log1pf(__expf(-fabsf(x))); }

__device__ __forceinline__ int map_row(int mode, int n) {
    if (mode == 1) { const int up = n >= DFF ? 1 : 0, i = n - up * DFF; return 256 * (i >> 7) + 128 * up + (i & 127); }
    if (mode == 3) { if (n < 1024) return n; const int q = n - 1024, part = q >> 10, i = q & 1023; return 1024 + 256 * (i >> 7) + 128 * part + (i & 127); }
    return n;
}
__device__ __forceinline__ void transpose_item(const float* W, int K, int N, bf16* WT, int mode, LAS float* scr, int item, int lane) {
    const int nblk = (N + 31) >> 5, kb = item / nblk, nb = item - kb * nblk, k0 = 64 * kb, n0 = 32 * nb;
    const int nl = n0 + (lane & 31); const bool nok = nl < N;
    float cs = 1.0f;
    if (mode == 2) { if (nl < 512) cs = 0.125f; else if (nl >= 2048 && nl < 2560) cs = 0.08838834764831845f; }
#pragma unroll 8
    for (int i = 0; i < 32; ++i) { const int kk = 2 * i + (lane >> 5); scr[kk * 33 + (lane & 31)] = nok ? W[(size_t)(k0 + kk) * N + nl] * cs : 0.f; }
    asm volatile("s_waitcnt lgkmcnt(0)" ::: "memory");
    const int c = lane & 7; const int r0 = map_row(mode, n0);
#pragma unroll
    for (int j = 0; j < 4; ++j) { const int n = (lane >> 3) + 8 * j; const LAS float* s = scr + (8 * c) * 33 + n;
        v4u o; o.x = pk2(s[0 * 33], s[1 * 33]); o.y = pk2(s[2 * 33], s[3 * 33]); o.z = pk2(s[4 * 33], s[5 * 33]); o.w = pk2(s[6 * 33], s[7 * 33]);
        *(v4u*)(WT + (size_t)(r0 + n) * K + k0 + 8 * c) = o; }
    asm volatile("s_waitcnt lgkmcnt(0)" ::: "memory");
}
__device__ __forceinline__ void convert_group(const float* W, int nmats, int K, int N, int NP, bf16* WT, int mode, LAS float* scr, int gw, int NGW, int lane) {
    const int per = (K >> 6) * ((N + 31) >> 5), tot = nmats * per;
    for (int it = gw; it < tot; it += NGW) { const int mt = it / per, r = it - mt * per; transpose_item(W + (size_t)mt * K * N, K, N, WT + (size_t)mt * NP * K, mode, scr, r, lane); }
}

__device__ __forceinline__ void ln_phase(float* Y, bf16* XN, const float* g, const float* b, int gw, int NGW, int lane) {
    for (int m = gw; m < M; m += NGW) {
        f32x4* yr = (f32x4*)(Y + (size_t)m * DM) + lane;
        f32x4 v[4]; float s = 0.f;
#pragma unroll
        for (int j = 0; j < 4; ++j) { v[j] = yr[64 * j]; s += (v[j].x + v[j].y) + (v[j].z + v[j].w); }
        const float mean = wave_sum(s) * (1.f / DM); float s2 = 0.f;
#pragma unroll
        for (int j = 0; j < 4; ++j) { v[j] = v[j] - mean; s2 += (v[j].x * v[j].x + v[j].y * v[j].y) + (v[j].z * v[j].z + v[j].w * v[j].w); }
        const float rstd = 1.f / sqrtf(wave_sum(s2) * (1.f / DM) + LN_EPS);
        v2u* o8 = (v2u*)(XN + (size_t)m * DM) + lane;
#pragma unroll
        for (int j = 0; j < 4; ++j) { const f32x4 gg = ((const f32x4*)g)[lane + 64 * j], bb = ((const f32x4*)b)[lane + 64 * j]; const f32x4 o = v[j] * rstd * gg + bb;
            yr[64 * j] = o; v2u w; w.x = pk2(o.x, o.y); w.y = pk2(o.z, o.w); o8[64 * j] = w; }
    }
}
__device__ __forceinline__ void copy_phase(const float* X, float* Y, bf16* XN, int gw, int NGW, int lane) {
    for (int m = gw; m < M; m += NGW) {
        const f32x4* xr = (const f32x4*)(X + (size_t)m * DM) + lane; f32x4* yr = (f32x4*)(Y + (size_t)m * DM) + lane; v2u* o8 = (v2u*)(XN + (size_t)m * DM) + lane;
#pragma unroll
        for (int j = 0; j < 4; ++j) { const f32x4 o = xr[64 * j]; yr[64 * j] = o; v2u w; w.x = pk2(o.x, o.y); w.y = pk2(o.z, o.w); o8[64 * j] = w; }
    }
}

__device__ __forceinline__ void na_phase(LAS unsigned char* lds, const bf16* AB, const float* rpb, bf16* MIX, int bid, int G, int tid) {
    const int lane = tid & 63, wave = tid >> 6, fr = lane & 15, fq = lane >> 4;
    constexpr int VP = 144;
    LAS unsigned char* Vs = lds;
    LAS float* Rp = (LAS float*)(lds + 9 * 64 * VP);
    for (int item = bid; item < NB * 8 * 16; item += G) {
        const int rp = item & 15, h = (item >> 4) & 7, b = item >> 7;
        const int r0 = 2 * rp; const int rsA = min(max(r0 - 4, 0), 24);
        __syncthreads();
        for (int ch = tid; ch < 9 * 64 * 8; ch += NT) { const int key = ch >> 3, c8 = ch & 7; const int row = rsA + (key >> 6);
            if (row < 32) { const v4u val = *(const v4u*)(AB + (size_t)(b * SEQ + row * 64 + (key & 63)) * AB_NP + 1024 + 64 * h + 8 * c8); *(LAS v4u*)(Vs + key * VP + c8 * 16) = val; } }
        for (int i = tid; i < 465; i += NT) Rp[i] = rpb[h * 465 + i];
        __syncthreads();
        const int j = wave & 3, r = r0 + (wave >> 2);
        const int rs = min(max(r - 4, 0), 24);
        const int kbs = min(max(16 * j - 8, 0), 32);
        const size_t tokq = (size_t)b * SEQ + r * 64 + 16 * j + fr;
        bf16x8 qop[2];
#pragma unroll
        for (int kb = 0; kb < 2; ++kb) qop[kb] = *(const bf16x8*)(AB + tokq * AB_NP + 64 * h + 32 * kb + 8 * fq);
        f32x4 s[16];
#pragma unroll
        for (int t = 0; t < 16; ++t) { const int kr = t >> 1, chh = t & 1; const size_t tokk = (size_t)b * SEQ + (rs + kr) * 64 + kbs + 16 * chh + fr;
            const bf16* kp = AB + tokk * AB_NP + 512 + 64 * h + 8 * fq; const bf16x8 k0 = *(const bf16x8*)kp, k1 = *(const bf16x8*)(kp + 32);
            f32x4 a = (f32x4){0.f, 0.f, 0.f, 0.f}; a = MFMA16(k0, qop[0], a); a = MFMA16(k1, qop[1], a); s[t] = a; }
        const int qc = 16 * j + fr; const int cs = min(max(qc - 8, 0), 48);
        float mx = -INFINITY;
#pragma unroll
        for (int t = 0; t < 16; ++t) { const int kr = t >> 1, chh = t & 1; const int dr = rs + kr - r + 7;
#pragma unroll
            for (int jj = 0; jj < 4; ++jj) { const int kc = kbs + 16 * chh + 4 * fq + jj; const bool ok = (kc >= cs) && (kc < cs + 16); const int dc = min(max(kc - qc + 15, 0), 30);
                const float v = ok ? s[t][jj] + Rp[dr * 31 + dc] : -INFINITY; s[t][jj] = v; mx = fmaxf(mx, v); } }
        mx = fmaxf(mx, __shfl_xor(mx, 16)); mx = fmaxf(mx, __shfl_xor(mx, 32));
        float l = 0.f;
#pragma unroll
        for (int t = 0; t < 16; ++t)
#pragma unroll
            for (int jj = 0; jj < 4; ++jj) { const float p = __expf(s[t][jj] - mx); l += p; s[t][jj] = p; }
        l += __shfl_xor(l, 16); l += __shfl_xor(l, 32);
        f32x4 o[4];
#pragma unroll
        for (int dt = 0; dt < 4; ++dt) o[dt] = (f32x4){0.f, 0.f, 0.f, 0.f};
        const int lr0 = rs - rsA;
#pragma unroll
        for (int kk = 0; kk < 8; ++kk) {
            v4u pw; pw.x = pk2(s[2 * kk][0], s[2 * kk][1]); pw.y = pk2(s[2 * kk][2], s[2 * kk][3]); pw.z = pk2(s[2 * kk + 1][0], s[2 * kk + 1][1]); pw.w = pk2(s[2 * kk + 1][2], s[2 * kk + 1][3]);
            const bf16x8 pop = __builtin_bit_cast(bf16x8, pw);
            const LAS unsigned char* vb = Vs + ((lr0 + kk) * 64 + kbs + 4 * fq) * VP + fr * 2;
#pragma unroll
            for (int dt = 0; dt < 4; ++dt) { bf16x8 vop;
#pragma unroll
                for (int i = 0; i < 8; ++i) vop[i] = (short)*(const LAS unsigned short*)(vb + ((i < 4 ? i : 12 + i)) * VP + dt * 32);
                o[dt] = MFMA16(pop, vop, o[dt]); }
        }
#pragma unroll
        for (int jj = 0; jj < 4; ++jj) { const float linv = 1.0f / __shfl(l, 4 * fq + jj); const size_t tok = (size_t)b * SEQ + r * 64 + 16 * j + 4 * fq + jj;
#pragma unroll
            for (int dt = 0; dt < 4; ++dt) MIX[tok * DM + 64 * h + 16 * dt + fr] = (bf16)(pk2(o[dt][jj] * linv, 0.f) & 0xffffu); }
    }
}

constexpr int CP = 272;
__device__ __forceinline__ void m1_phase(LAS unsigned char* lds, const bf16* AB, const float* GATES, const float* gate_b, bf16* DC, float* DN, float* SC, int bid, int G, int tid) {
    const int lane = tid & 63, wave = tid >> 6, fr = lane & 15, fq = lane >> 4;
    LAS unsigned char* Ks = lds; LAS unsigned char* Vs = lds + 64 * CP; LAS float* was = (LAS float*)(lds + 2 * 64 * CP);
    for (int item = bid; item < 4096; item += G) {
        const int c = item & 31, dir = (item >> 5) & 1, hh = (item >> 6) & 3, b = item >> 8;
        const size_t tok0 = (size_t)b * SEQ + 64 * c;
        __syncthreads();
        for (int ch = tid; ch < 2048; ch += NT) { const int mat = ch >> 10, row = (ch >> 4) & 63, c16 = ch & 15;
            const v4u val = *(const v4u*)(AB + (tok0 + row) * AB_NP + 2048 + 512 * mat + 128 * hh + 8 * c16); *(LAS v4u*)((mat ? Vs : Ks) + row * CP + c16 * 16) = val; }
        {
            const size_t tok = tok0 + lane;
            const float gi = GATES[tok * 16 + 8 * dir + hh] + gate_b[8 * dir + hh], gf = GATES[tok * 16 + 8 * dir + 4 + hh] + gate_b[8 * dir + 4 + hh];
            const float lf = log_sigmoid(gf); const float bcs = scan_sum(lf, lane, dir); const float g = __shfl(bcs, dir ? 0 : 63);
            const float a = g - bcs + gi; const float ml = wave_max(a); const float wa = __expf(a - ml);
            if (wave == 0) { was[lane] = wa; if (lane == 0) { SC[32 * item] = g; SC[32 * item + 1] = ml; } }
        }
        __syncthreads();
        if (tid < 128) { float acc = 0.f;
#pragma unroll 8
            for (int s = 0; s < 64; ++s) acc += was[s] * bf2f(*(const LAS unsigned short*)(Ks + s * CP + tid * 2));
            DN[(size_t)item * 128 + tid] = acc; }
        bf16x8 vop[2];
#pragma unroll
        for (int kb = 0; kb < 2; ++kb) { float t[8];
#pragma unroll
            for (int i = 0; i < 8; ++i) { const int s = 32 * kb + 8 * fq + i; t[i] = was[s] * bf2f(*(const LAS unsigned short*)(Vs + s * CP + (16 * wave + fr) * 2)); }
            v4u w; w.x = pk2(t[0], t[1]); w.y = pk2(t[2], t[3]); w.z = pk2(t[4], t[5]); w.w = pk2(t[6], t[7]); vop[kb] = __builtin_bit_cast(bf16x8, w); }
        bf16* dcp = DC + (size_t)item * 16384 + (size_t)(16 * wave + fr) * 128 + 4 * fq;
#pragma unroll
        for (int nt = 0; nt < 8; ++nt) { f32x4 acc = (f32x4){0.f, 0.f, 0.f, 0.f};
#pragma unroll
            for (int kb = 0; kb < 2; ++kb) { bf16x8 kop;
#pragma unroll
                for (int i = 0; i < 8; ++i) kop[i] = (short)*(const LAS unsigned short*)(Ks + (32 * kb + 8 * fq + i) * CP + (16 * nt + fr) * 2);
                acc = MFMA16(kop, vop[kb], acc); }
            v2u w; w.x = pk2(acc[0], acc[1]); w.y = pk2(acc[2], acc[3]); *(v2u*)(dcp + 16 * nt) = w; }
    }
}
__device__ __forceinline__ void m2_phase(bf16* DC, float* DN, const float* SC, float* MS, int bid, int G, int tid) {
    for (int gidx = bid * NT + tid; gidx < 128 * 2048; gidx += G * NT) {
        const int seq = gidx >> 11, e8 = gidx & 2047, dir = seq & 1;
        float C0 = 0.f, C1 = 0.f, C2 = 0.f, C3 = 0.f, C4 = 0.f, C5 = 0.f, C6 = 0.f, C7 = 0.f, m = 0.f;
        for (int step = 0; step < 32; ++step) { const int c = dir ? 31 - step : step; const int item = seq * 32 + c;
            const float g = SC[32 * item], ml = SC[32 * item + 1];
            v4u* p = (v4u*)(DC + (size_t)item * 16384 + (size_t)e8 * 8); const v4u raw = *p;
            v4u o; o.x = pk2(C0, C1); o.y = pk2(C2, C3); o.z = pk2(C4, C5); o.w = pk2(C6, C7); *p = o;
            if (e8 == 0) MS[item] = m;
            const float mn = fmaxf(g + m, ml); const float dec = __expf(g + m - mn), sc = __expf(ml - mn);
            C0 = dec * C0 + sc * bflo(raw.x); C1 = dec * C1 + sc * bfhi(raw.x); C2 = dec * C2 + sc * bflo(raw.y); C3 = dec * C3 + sc * bfhi(raw.y);
            C4 = dec * C4 + sc * bflo(raw.z); C5 = dec * C5 + sc * bfhi(raw.z); C6 = dec * C6 + sc * bflo(raw.w); C7 = dec * C7 + sc * bfhi(raw.w);
            m = mn; }
    }
    for (int gidx = bid * NT + tid; gidx < 128 * 128; gidx += G * NT) {
        const int seq = gidx >> 7, kd = gidx & 127, dir = seq & 1;
        float n = 0.f, m = 0.f;
        for (int step = 0; step < 32; ++step) { const int c = dir ? 31 - step : step; const int item = seq * 32 + c;
            const float g = SC[32 * item], ml = SC[32 * item + 1];
            float* p = DN + (size_t)item * 128 + kd; const float raw = *p; *p = n;
            const float mn = fmaxf(g + m, ml); const float dec = __expf(g + m - mn), sc = __expf(ml - mn);
            n = dec * n + sc * raw; m = mn; }
    }
}
__device__ __forceinline__ void m3_phase(LAS unsigned char* lds, const bf16* AB, const float* GATES, const float* gate_b, const bf16* CPV, const float* NP, const float* MS,
                                         const float* gn_g, bf16* MIX, int bid, int G, int tid) {
    const int lane = tid & 63, wave = tid >> 6, fr = lane & 15, fq = lane >> 4;
    constexpr int PP = 144;
    LAS unsigned char* Qs = lds; LAS unsigned char* Ks = lds + 64 * CP; LAS unsigned char* Vs = lds + 2 * 64 * CP; LAS unsigned char* Ps = lds + 3 * 64 * CP;
    LAS float* sb = (LAS float*)(lds + 3 * 64 * CP + 64 * PP); LAS float* su = sb + 64; LAS float* sint = su + 64; LAS float* sen = sint + 64; LAS float* sscale = sen + 64;
    LAS float* npv = sscale + 64; LAS float* part = npv + 128;
    for (int item = (bid + M3_SHIFT) % G; item < 2048; item += G) {
        const int c = item & 31, hh = (item >> 5) & 3, b = item >> 7;
        const size_t tok0 = (size_t)b * SEQ + 64 * c;
        __syncthreads();
        for (int ch = tid; ch < 3072; ch += NT) { const int mat = ch >> 10, row = (ch >> 4) & 63, c16 = ch & 15;
            const v4u val = *(const v4u*)(AB + (tok0 + row) * AB_NP + 1536 + 512 * mat + 128 * hh + 8 * c16); *(LAS v4u*)(lds + mat * 64 * CP + row * CP + c16 * 16) = val; }
        f32x4 hsum[4];
#pragma unroll
        for (int tt = 0; tt < 4; ++tt) hsum[tt] = (f32x4){0.f, 0.f, 0.f, 0.f};
#pragma unroll 1
        for (int dir = 0; dir < 2; ++dir) {
            const int it2 = ((b * 4 + hh) * 2 + dir) * 32 + c;
            {
                const size_t tok = tok0 + lane;
                const float gi = GATES[tok * 16 + 8 * dir + hh] + gate_b[8 * dir + hh], gf = GATES[tok * 16 + 8 * dir + 4 + hh] + gate_b[8 * dir + 4 + hh];
                const float lf = log_sigmoid(gf); const float bcs = scan_sum(lf, lane, dir); const float mprev = MS[it2];
                const float inter = bcs + mprev; const float uu = gi - bcs; const float pm = scan_max(uu, lane, dir); const float mt = fmaxf(inter, bcs + pm);
                if (wave == 0) { sb[lane] = bcs - mt; su[lane] = uu; sint[lane] = __expf(inter - mt); sen[lane] = __expf(-mt); }
                if (tid >= 64 && tid < 192) npv[tid - 64] = NP[(size_t)it2 * 128 + tid - 64];
            }
            __syncthreads();
            {
                const int tt = wave >> 1;
#pragma unroll
                for (int q2 = 0; q2 < 2; ++q2) { const int st = 2 * (wave & 1) + q2; f32x4 acc = (f32x4){0.f, 0.f, 0.f, 0.f};
#pragma unroll
                    for (int kb = 0; kb < 4; ++kb) { const bf16x8 qop = *(const LAS bf16x8*)(Qs + (16 * tt + fr) * CP + (32 * kb + 8 * fq) * 2); const bf16x8 kop = *(const LAS bf16x8*)(Ks + (16 * st + fr) * CP + (32 * kb + 8 * fq) * 2);
                        acc = MFMA16(qop, kop, acc); }
                    const int sig = 16 * st + fr; const float usig = su[sig];
#pragma unroll
                    for (int jj = 0; jj < 4; ++jj) { const int tau = 16 * tt + 4 * fq + jj; const bool ok = dir ? (sig >= tau) : (sig <= tau);
                        const float w = ok ? __expf(sb[tau] + usig) : 0.f; const float p = ok ? acc[jj] * w : 0.f;
                        *(LAS unsigned short*)(Ps + tau * PP + sig * 2) = (unsigned short)(pk2(p, 0.f) & 0xffffu); } }
            }
            __syncthreads();
            {
                const int tau = tid >> 3, pt = tid & 7;
                const v4u pv = *(const LAS v4u*)(Ps + tau * PP + pt * 16);
                float dsum = ((bflo(pv.x) + bfhi(pv.x)) + (bflo(pv.y) + bfhi(pv.y))) + ((bflo(pv.z) + bfhi(pv.z)) + (bflo(pv.w) + bfhi(pv.w)));
                float qn = 0.f;
#pragma unroll
                for (int hf = 0; hf < 2; ++hf) { const v4u qv = *(const LAS v4u*)(Qs + tau * CP + (pt * 16 + hf * 8) * 2); const LAS float* np = npv + pt * 16 + hf * 8;
                    qn += bflo(qv.x) * np[0] + bfhi(qv.x) * np[1] + bflo(qv.y) * np[2] + bfhi(qv.y) * np[3] + bflo(qv.z) * np[4] + bfhi(qv.z) * np[5] + bflo(qv.w) * np[6] + bfhi(qv.w) * np[7]; }
                dsum += __shfl_xor(dsum, 1); dsum += __shfl_xor(dsum, 2); dsum += __shfl_xor(dsum, 4);
                qn += __shfl_xor(qn, 1); qn += __shfl_xor(qn, 2); qn += __shfl_xor(qn, 4);
                const float den = dsum + sint[tau] * qn; const float scl = 1.0f / fmaxf(fabsf(den), sen[tau]);
                if (pt == 0) sscale[tau] = scl;
            }
            __syncthreads();
            {
                bf16x8 vop[2], cop[4];
#pragma unroll
                for (int kb = 0; kb < 2; ++kb)
#pragma unroll
                    for (int i = 0; i < 8; ++i) vop[kb][i] = (short)*(const LAS unsigned short*)(Vs + (32 * kb + 8 * fq + i) * CP + (16 * wave + fr) * 2);
                const bf16* cpp = CPV + (size_t)it2 * 16384 + (size_t)(16 * wave + fr) * 128 + 8 * fq;
#pragma unroll
                for (int kb = 0; kb < 4; ++kb) cop[kb] = *(const bf16x8*)(cpp + 32 * kb);
#pragma unroll
                for (int tt = 0; tt < 4; ++tt) { f32x4 ai = (f32x4){0.f, 0.f, 0.f, 0.f}, ae = (f32x4){0.f, 0.f, 0.f, 0.f};
#pragma unroll
                    for (int kb = 0; kb < 2; ++kb) { const bf16x8 pop = *(const LAS bf16x8*)(Ps + (16 * tt + fr) * PP + (32 * kb + 8 * fq) * 2); ai = MFMA16(vop[kb], pop, ai); }
#pragma unroll
                    for (int kb = 0; kb < 4; ++kb) { const bf16x8 qop = *(const LAS bf16x8*)(Qs + (16 * tt + fr) * CP + (32 * kb + 8 * fq) * 2); ae = MFMA16(cop[kb], qop, ae); }
                    const int tau = 16 * tt + fr; const float si = sint[tau], sc = sscale[tau];
                    hsum[tt] += (ai + ae * si) * sc; }
            }
            __syncthreads();
        }
#pragma unroll
        for (int tt = 0; tt < 4; ++tt) { const f32x4 hv = hsum[tt]; float s1 = (hv[0] + hv[1]) + (hv[2] + hv[3]); float s2 = (hv[0] * hv[0] + hv[1] * hv[1]) + (hv[2] * hv[2] + hv[3] * hv[3]);
            s1 += __shfl_xor(s1, 16); s1 += __shfl_xor(s1, 32); s2 += __shfl_xor(s2, 16); s2 += __shfl_xor(s2, 32);
            if (fq == 0) { part[(wave * 64 + 16 * tt + fr) * 2] = s1; part[(wave * 64 + 16 * tt + fr) * 2 + 1] = s2; } }
        __syncthreads();
#pragma unroll
        for (int tt = 0; tt < 4; ++tt) { const int tau = 16 * tt + fr; float S1 = 0.f, S2 = 0.f;
#pragma unroll
            for (int w = 0; w < 8; ++w) { S1 += part[(w * 64 + tau) * 2]; S2 += part[(w * 64 + tau) * 2 + 1]; }
            const float mean = S1 * (1.f / 128.f); const float var = fmaxf(S2 * (1.f / 128.f) - mean * mean, 0.f); const float rstd = 1.0f / sqrtf(var + LN_EPS);
            const size_t tokm = tok0 + tau; const int vc = 128 * hh + 16 * wave + 4 * fq;
            const v2u ob = *(const v2u*)(AB + tokm * AB_NP + 3072 + vc); const f32x4 gn = *(const f32x4*)(gn_g + vc);
            const f32x4 hv = hsum[tt];
            const float o0 = bflo(ob.x), o1 = bfhi(ob.x), o2 = bflo(ob.y), o3 = bfhi(ob.y);
            const float y0 = (hv[0] - mean) * rstd * gn[0] * __builtin_amdgcn_rcpf(1.f + __expf(-o0));
            const float y1 = (hv[1] - mean) * rstd * gn[1] * __builtin_amdgcn_rcpf(1.f + __expf(-o1));
            const float y2 = (hv[2] - mean) * rstd * gn[2] * __builtin_amdgcn_rcpf(1.f + __expf(-o2));
            const float y3 = (hv[3] - mean) * rstd * gn[3] * __builtin_amdgcn_rcpf(1.f + __expf(-o3));
            v2u w; w.x = pk2(y0, y1); w.y = pk2(y2, y3); *(v2u*)(MIX + tokm * DM + 512 + vc) = w; }
    }
}

__device__ __forceinline__ void conv_phase(const bf16* BG, const bf16* U, const float* cw, const float* cb, bf16* MIX, int bid, int G, int tid) {
    for (int idx = bid * NT + tid; idx < M * 128; idx += G * NT) {
        const int m = idx >> 7, c8 = (idx & 127) * 8, s = m & (SEQ - 1);
        const v4u uc = *(const v4u*)(U + (size_t)m * DM + c8);
        v4u up = (v4u){0u, 0u, 0u, 0u}, un = (v4u){0u, 0u, 0u, 0u};
        if (s > 0) up = *(const v4u*)(U + (size_t)(m - 1) * DM + c8);
        if (s < SEQ - 1) un = *(const v4u*)(U + (size_t)(m + 1) * DM + c8);
        const v4u bg = *(const v4u*)(BG + (size_t)m * DM + c8);
        const f32x4 w0a = *(const f32x4*)(cw + c8), w0b = *(const f32x4*)(cw + c8 + 4), w1a = *(const f32x4*)(cw + DM + c8), w1b = *(const f32x4*)(cw + DM + c8 + 4);
        const f32x4 w2a = *(const f32x4*)(cw + 2 * DM + c8), w2b = *(const f32x4*)(cw + 2 * DM + c8 + 4), ba = *(const f32x4*)(cb + c8), bb = *(const f32x4*)(cb + c8 + 4);
        v4u o;
        o.x = pk2(bflo(bg.x) * (w0a[0] * bflo(up.x) + w1a[0] * bflo(uc.x) + w2a[0] * bflo(un.x) + ba[0]), bfhi(bg.x) * (w0a[1] * bfhi(up.x) + w1a[1] * bfhi(uc.x) + w2a[1] * bfhi(un.x) + ba[1]));
        o.y = pk2(bflo(bg.y) * (w0a[2] * bflo(up.y) + w1a[2] * bflo(uc.y) + w2a[2] * bflo(un.y) + ba[2]), bfhi(bg.y) * (w0a[3] * bfhi(up.y) + w1a[3] * bfhi(uc.y) + w2a[3] * bfhi(un.y) + ba[3]));
        o.z = pk2(bflo(bg.z) * (w0b[0] * bflo(up.z) + w1b[0] * bflo(uc.z) + w2b[0] * bflo(un.z) + bb[0]), bfhi(bg.z) * (w0b[1] * bfhi(up.z) + w1b[1] * bfhi(uc.z) + w2b[1] * bfhi(un.z) + bb[1]));
        o.w = pk2(bflo(bg.w) * (w0b[2] * bflo(up.w) + w1b[2] * bflo(uc.w) + w2b[2] * bflo(un.w) + bb[2]), bfhi(bg.w) * (w0b[3] * bfhi(up.w) + w1b[3] * bfhi(uc.w) + w2b[3] * bfhi(un.w) + bb[3]));
        *(v4u*)(MIX + (size_t)m * DM + c8) = o;
    }
}

struct Args { const float* in[14]; float* out; unsigned char* ws; };
#define GRID_SYNC() do { asm volatile("s_waitcnt vmcnt(0) lgkmcnt(0)" ::: "memory"); __syncthreads(); grid.sync(); __builtin_amdgcn_fence(__ATOMIC_ACQUIRE, "agent"); asm volatile("s_waitcnt vmcnt(0)" ::: "memory"); __syncthreads(); } while (0)
__device__ __forceinline__ int opaque_tid() { int t = threadIdx.x; asm volatile("" : "+v"(t)); return t; }
__global__ void __launch_bounds__(NT, 2) fwd_megakernel(Args args) {
    extern __shared__ __attribute__((aligned(16))) unsigned char lds_raw[];
    cg::grid_group grid = cg::this_grid();
    LAS unsigned char* lds = (LAS unsigned char*)lds_raw;
    const int G = gridDim.x, bid = blockIdx.x;

    {
        const int tid = opaque_tid(), lane = tid & 63, wave = tid >> 6; const int gw = bid * NWAVES + wave, NGW = G * NWAVES;
        unsigned char* ws = args.ws;
        LAS float* scr = (LAS float*)(lds + wave * 16384);
        convert_group(args.in[3], 8, DM, NFF, NFF, (bf16*)(ws + WS_WFI), 1, scr, gw, NGW, lane);
        convert_group(args.in[4], 8, DFF, DM, DM, (bf16*)(ws + WS_WFO), 0, scr, gw, NGW, lane);
        convert_group(args.in[5], 2, DM, AB_N, AB_NP, (bf16*)(ws + WS_WAI), 2, scr, gw, NGW, lane);
        convert_group(args.in[9], 2, DM, DM, DM, (bf16*)(ws + WS_WAO), 0, scr, gw, NGW, lane);
        convert_group(args.in[10], 2, DM, SC_N, SC_N, (bf16*)(ws + WS_WSI), 3, scr, gw, NGW, lane);
        convert_group(args.in[13], 2, DM, DM, DM, (bf16*)(ws + WS_WSO), 0, scr, gw, NGW, lane);
        copy_phase(args.in[0], args.out, (bf16*)(ws + WS_XN), gw, NGW, lane);
    }
    GRID_SYNC();

#pragma unroll 1
    for (int sl = 0; sl < N_SL; ++sl) {
        const int layer = sl / 3, sub = sl - 3 * layer;
        unsigned char* ws = args.ws; asm volatile("" : "+s"(ws));
        float* Y = args.out;
        bf16* XN = (bf16*)(ws + WS_XN); bf16* MIX = (bf16*)(ws + WS_MIX); bf16* BIG = (bf16*)(ws + WS_BIG);
        const bf16* A2; const bf16* B2; int K2; float scale2;
        if (sub != 1) {
            const int j = sub >> 1;
            pg8::Gemm g{XN, (const bf16*)(ws + WS_WFI) + (size_t)(layer * 2 + j) * NFF * DM, M, NFF, DM}; pg8::StaticOrder S; S.init(M, NFF, G, bid);
            pg8::EpiSwiGLU E{BIG, DFF};
            pg8::gemm_phase<pg8::EpiSwiGLU, pg8::StaticOrder, true, true>(lds, g, S, E);
            A2 = BIG; B2 = (const bf16*)(ws + WS_WFO) + (size_t)(layer * 2 + j) * DM * DFF; K2 = DFF; scale2 = 0.5f;
            GRID_SYNC();
        } else if ((layer & 1) == 0) {
            const int e = layer >> 1;
            float* GATES = (float*)(ws + WS_GATES); bf16* DC = (bf16*)(ws + WS_DC); float* DN = (float*)(ws + WS_DN); float* SC = (float*)(ws + WS_SC); float* MS = (float*)(ws + WS_MS);
            {
                pg8::Gemm g{XN, (const bf16*)(ws + WS_WAI) + (size_t)e * AB_NP * DM, M, AB_NP, DM}; pg8::StaticOrder S; S.init(M, AB_NP, G, bid);
                pg8::EpiAB E{BIG, AB_NP, GATES, 14};
                pg8::gemm_phase<pg8::EpiAB, pg8::StaticOrder, true, true>(lds, g, S, E);
            }
            GRID_SYNC();
            const float* gate_b = args.in[6] + e * 16;
#ifndef SKIP_NA
            na_phase(lds, BIG, args.in[7] + (size_t)e * 8 * 465, MIX, bid, G, opaque_tid());
#else
            { const int t_ = opaque_tid(); for (int i = bid * NT + t_; i < M * 64; i += G * NT) { const int m_ = i >> 6, c_ = (i & 63) * 8; *(v4u*)(MIX + (size_t)m_ * DM + c_) = (v4u){0u, 0u, 0u, 0u}; } }
#endif
#ifndef SKIP_M
#ifndef ONLY_M3
            m1_phase(lds, BIG, GATES, gate_b, DC, DN, SC, bid, G, opaque_tid());
            GRID_SYNC();
            m2_phase(DC, DN, SC, MS, bid, G, opaque_tid());
#else
            { const int t_ = opaque_tid(); for (size_t i = (size_t)bid * NT + t_; i < (size_t)4096 * 2048; i += (size_t)G * NT) *(v4u*)(DC + i * 8) = (v4u){0u, 0u, 0u, 0u};
              for (int i = bid * NT + t_; i < 4096 * 128; i += G * NT) DN[i] = 0.f; for (int i = bid * NT + t_; i < 4096; i += G * NT) MS[i] = 0.f; }
#endif
            GRID_SYNC();
#ifndef M3_LITE
            m3_phase(lds, BIG, GATES, gate_b, DC, DN, MS, args.in[8] + e * 512, MIX, bid, G, opaque_tid());
#else
            { const int t_ = opaque_tid(); for (int i = bid * NT + t_; i < M * 64; i += G * NT) { const int m_ = i >> 6, c_ = 512 + (i & 63) * 8;
                float a0 = 0.f, a1 = 0.f, a2 = 0.f, a3 = 0.f, a4 = 0.f, a5 = 0.f, a6 = 0.f, a7 = 0.f;
                for (int k = 0; k < 4; ++k) { const v4u r = *(const v4u*)(DC + ((size_t)i + (size_t)k * M * 64) * 8);
                    a0 += bflo(r.x); a1 += bfhi(r.x); a2 += bflo(r.y); a3 += bfhi(r.y); a4 += bflo(r.z); a5 += bfhi(r.z); a6 += bflo(r.w); a7 += bfhi(r.w); }
                const float e_ = MS[i & 4095] * 0.01f + DN[i & (4096 * 128 - 1)] * 0.01f;
                v4u o; o.x = pk2(a0 * 0.05f + e_, a1 * 0.05f); o.y = pk2(a2 * 0.05f, a3 * 0.05f); o.z = pk2(a4 * 0.05f, a5 * 0.05f); o.w = pk2(a6 * 0.05f, a7 * 0.05f);
                *(v4u*)(MIX + (size_t)m_ * DM + c_) = o; } }
#endif
#else
            { const int t_ = opaque_tid(); for (int i = bid * NT + t_; i < M * 64; i += G * NT) { const int m_ = i >> 6, c_ = 512 + (i & 63) * 8; *(v4u*)(MIX + (size_t)m_ * DM + c_) = (v4u){0u, 0u, 0u, 0u}; } }
#endif
            __syncthreads();
            A2 = MIX; B2 = (const bf16*)(ws + WS_WAO) + (size_t)e * DM * DM; K2 = DM; scale2 = 1.0f;
            GRID_SYNC();
        } else {
            const int o = layer >> 1;
            {
                pg8::Gemm g{XN, (const bf16*)(ws + WS_WSI) + (size_t)o * SC_N * DM, M, SC_N, DM}; pg8::StaticOrder S; S.init(M, SC_N, G, bid);
                pg8::EpiConvIn E{BIG, BIG + (size_t)M * DM};
                pg8::gemm_phase<pg8::EpiConvIn, pg8::StaticOrder, true, true>(lds, g, S, E);
            }
            GRID_SYNC();
            conv_phase(BIG, BIG + (size_t)M * DM, args.in[11] + (size_t)o * 3 * DM, args.in[12] + (size_t)o * DM, MIX, bid, G, opaque_tid());
            A2 = MIX; B2 = (const bf16*)(ws + WS_WSO) + (size_t)o * DM * DM; K2 = DM; scale2 = 1.0f;
            GRID_SYNC();
        }
        {
            pg8::Gemm g{A2, B2, M, DM, K2}; pg8::StaticOrder S; S.init(M, DM, G, bid);
            pg8::EpiResid E{Y, DM, DN_ALPHA, scale2};
            pg8::gemm_phase<pg8::EpiResid, pg8::StaticOrder, true, true>(lds, g, S, E);
        }
        GRID_SYNC();
        {
            const int tid = opaque_tid(), lane = tid & 63, wave = tid >> 6;
            ln_phase(Y, XN, args.in[1] + (size_t)(layer * 3 + sub) * DM, args.in[2] + (size_t)(layer * 3 + sub) * DM, bid * NWAVES + wave, G * NWAVES, lane);
        }
        GRID_SYNC();
    }
}

extern "C" void kernel_launch(void* const* d_in, const int* in_sizes, int n_in, void* d_out, int out_size, void* d_ws, size_t ws_size, hipStream_t stream) {
    static int grid = 0;
    if (grid == 0) {
        if (n_in != 14 || out_size != M * DM || ws_size < WS_END) { fprintf(stderr, "kernel_launch: unexpected problem (n_in %d out %d ws %zu need %zu)\n", n_in, out_size, ws_size, (size_t)WS_END); grid = -1; return; }
        int dev = 0, cus = 0, per_cu = 0;
        hipGetDevice(&dev); hipDeviceGetAttribute(&cus, hipDeviceAttributeMultiprocessorCount, dev);
        if (hipFuncSetAttribute((const void*)fwd_megakernel, hipFuncAttributeMaxDynamicSharedMemorySize, LDS_BYTES) != hipSuccess) { fprintf(stderr, "kernel_launch: hipFuncSetAttribute failed\n"); grid = -1; return; }
        if (hipOccupancyMaxActiveBlocksPerMultiprocessor(&per_cu, (const void*)fwd_megakernel, NT, LDS_BYTES) != hipSuccess || per_cu < 1) { fprintf(stderr, "kernel_launch: occupancy query gave %d\n", per_cu); per_cu = 1; }
        (void)hipGetLastError();
        grid = cus;
    }
    if (grid < 0) return;
    Args a{};
    for (int i = 0; i < 14; ++i) a.in[i] = (const float*)d_in[i];
    a.out = (float*)d_out; a.ws = (unsigned char*)d_ws;
    void* kargs[] = {&a};
    hipError_t e = hipLaunchCooperativeKernel((const void*)fwd_megakernel, dim3(grid), dim3(NT), kargs, LDS_BYTES, stream);
    if (e != hipSuccess) fprintf(stderr, "cooperative launch failed: %s (grid %d)\n", hipGetErrorString(e), grid);
}
```

```cpp
#include <hip/hip_runtime.h>
#include <hip/hip_cooperative_groups.h>
#include <cstdio>
#include <cstdint>
#include <cmath>
namespace cg = cooperative_groups;
namespace pg8 {
#define PG8_LAS __attribute__((address_space(3)))
typedef unsigned short bf16_t;
typedef short bf16x8 __attribute__((ext_vector_type(8)));
typedef float f32x4 __attribute__((ext_vector_type(4)));
typedef unsigned u32x4 __attribute__((ext_vector_type(4)));
constexpr int BM = 256, BK = 64, HALF = 128, HTB = HALF * BK * 2  , STAGE_BYTES = 8 * HTB, NXCD = 8, WGM = 8;

__host__ __device__ __forceinline__ int lds_byte(int r, int c) { const int st = (r >> 4) * 2 + (c >> 5), rr = r & 15, cc = c & 31, ob = rr * 64 + cc * 2; return st * 1024 + (ob ^ (((ob >> 9) & 1) << 5)); }
__host__ __device__ __forceinline__ void stage_rc(int b, int& R, int& C) { const int st = b / 1024, sb = b % 1024, swz = sb ^ (((sb >> 9) & 1) << 5); R = (st >> 1) * 16 + swz / 64; C = (st & 1) * 32 + (swz % 64) / 2; }
__host__ __device__ __forceinline__ int perm32(int rho) { const int n = rho >> 4, i = rho & 15; return 8 * (i >> 2) + 4 * n + (i & 3); }

struct Unit { int pm, pn; };
struct Gemm { const bf16_t* A; const bf16_t* Bt; int M, N, K; };

struct StaticOrder {
    int nM, nN, nwg, G, c;
    __host__ __device__ void init(int M, int N, int G_, int c_) { nM = M / BM; nN = N / BM; nwg = nM * nN; G = G_; c = c_; }
    __host__ __device__ bool next(int i, Unit& u) const {
        const long L = (long)i * G + c; if (L >= nwg) return false;
        int wgid = (int)L; { const int q = nwg / NXCD, r = nwg % NXCD, xcd = wgid % NXCD, off = wgid / NXCD; wgid = (xcd < r ? xcd * (q + 1) : r * (q + 1) + (xcd - r) * q) + off; }
        const int nig = WGM * nN, gid = wgid / nig, fm = gid * WGM, gsz = (nM - fm) < WGM ? (nM - fm) : WGM;
        u.pm = fm + ((wgid % nig) % gsz); u.pn = (wgid % nig) / gsz; return true;
    }
    __device__ __forceinline__ void a_ready(const Unit&) const {}
    __device__ __forceinline__ void done(const Unit&) const {}
};

typedef float f32x2_cv __attribute__((ext_vector_type(2))); typedef __bf16 bf16x2_cv __attribute__((ext_vector_type(2)));
__device__ __forceinline__ unsigned cvt_pk_bf16(float lo, float hi) { const f32x2_cv v = {lo, hi}; const bf16x2_cv b = __builtin_convertvector(v, bf16x2_cv); return __builtin_bit_cast(unsigned, b); }
__device__ __forceinline__ float silu_f(float x) { return x * __builtin_amdgcn_rcpf(1.0f + __expf(-x)); }
struct EpiSwiGLU {
    static constexpr bool PERM = true, AFTER_DRAIN = false;
    bf16_t* H; int ldh;
    __device__ __forceinline__ void operator()(const f32x4 (&acc)[2][2][4][2], const Unit& u, int wr, int wc, int fr, int fq) const {
        const int row0 = u.pm * BM + wr * 64 + fr; const int col0 = u.pn * HALF + wc * 32 + 8 * fq;
#pragma unroll
        for (int ai = 0; ai < 2; ++ai)
#pragma unroll
            for (int m = 0; m < 4; ++m) {
                bf16_t* p = H + (size_t)(row0 + ai * HALF + m * 16) * ldh + col0;
                const f32x4 g0 = acc[ai][0][m][0], g1 = acc[ai][0][m][1], u0 = acc[ai][1][m][0], u1 = acc[ai][1][m][1];
                u32x4 w;
                w.x = cvt_pk_bf16(silu_f(g0[0]) * u0[0], silu_f(g0[1]) * u0[1]);
                w.y = cvt_pk_bf16(silu_f(g0[2]) * u0[2], silu_f(g0[3]) * u0[3]);
                w.z = cvt_pk_bf16(silu_f(g1[0]) * u1[0], silu_f(g1[1]) * u1[1]);
                w.w = cvt_pk_bf16(silu_f(g1[2]) * u1[2], silu_f(g1[3]) * u1[3]);
                *(u32x4*)p = w;
            }
    }
};
struct EpiResid {
    static constexpr bool PERM = false, AFTER_DRAIN = false;
    float* Y; int ldc; float alpha, scale;
    __device__ __forceinline__ void operator()(const f32x4 (&acc)[2][2][4][2], const Unit& u, int wr, int wc, int fr, int fq) const {
        const int row0 = u.pm * BM + wr * 64 + fr; const int col0 = u.pn * BM + wc * 32 + 4 * fq;
#pragma unroll
        for (int ai = 0; ai < 2; ++ai)
#pragma unroll
            for (int m = 0; m < 4; ++m) {
                float* rp = Y + (size_t)(row0 + ai * HALF + m * 16) * ldc + col0;
#pragma unroll
                for (int bj = 0; bj < 2; ++bj)
#pragma unroll
                    for (int n = 0; n < 2; ++n) { f32x4* p = (f32x4*)(rp + bj * HALF + n * 16); const f32x4 x = *p; *p = x * alpha + acc[ai][bj][m][n] * scale; }
                asm volatile("" ::: "memory");
            }
    }
};
struct EpiAB {
    static constexpr bool PERM = true, AFTER_DRAIN = false;
    bf16_t* O; int ldc; float* gates; int gate_tile;
    __device__ __forceinline__ void operator()(const f32x4 (&acc)[2][2][4][2], const Unit& u, int wr, int wc, int fr, int fq) const {
        const int row0 = u.pm * BM + wr * 64 + fr;
        if (u.pn == gate_tile) {
            if (wc == 0 && fq < 2) {
#pragma unroll
                for (int ai = 0; ai < 2; ++ai)
#pragma unroll
                    for (int m = 0; m < 4; ++m) { float* gp = gates + (size_t)(row0 + ai * HALF + m * 16) * 16 + 8 * fq; *(f32x4*)gp = acc[ai][0][m][0]; *(f32x4*)(gp + 4) = acc[ai][0][m][1]; }
            }
            return;
        }
        const int col0 = u.pn * BM + wc * 32 + 8 * fq;
#pragma unroll
        for (int ai = 0; ai < 2; ++ai)
#pragma unroll
            for (int m = 0; m < 4; ++m) { bf16_t* rowp = O + (size_t)(row0 + ai * HALF + m * 16) * ldc + col0;
#pragma unroll
                for (int bj = 0; bj < 2; ++bj) { const f32x4 v0 = acc[ai][bj][m][0], v1 = acc[ai][bj][m][1];
                    u32x4 w; w.x = cvt_pk_bf16(v0[0], v0[1]); w.y = cvt_pk_bf16(v0[2], v0[3]); w.z = cvt_pk_bf16(v1[0], v1[1]); w.w = cvt_pk_bf16(v1[2], v1[3]);
                    *(u32x4*)(rowp + bj * HALF) = w; } }
    }
};
struct EpiConvIn {
    static constexpr bool PERM = true, AFTER_DRAIN = false;
    bf16_t* BG; bf16_t* U;
    __device__ __forceinline__ void operator()(const f32x4 (&acc)[2][2][4][2], const Unit& u, int wr, int wc, int fr, int fq) const {
        const int row0 = u.pm * BM + wr * 64 + fr;
        if (u.pn < 4) {
            const int col0 = u.pn * BM + wc * 32 + 8 * fq;
#pragma unroll
            for (int ai = 0; ai < 2; ++ai)
#pragma unroll
                for (int m = 0; m < 4; ++m) { bf16_t* rowp = BG + (size_t)(row0 + ai * HALF + m * 16) * 1024 + col0;
#pragma unroll
                    for (int bj = 0; bj < 2; ++bj) { const f32x4 v0 = acc[ai][bj][m][0], v1 = acc[ai][bj][m][1];
                        u32x4 w; w.x = cvt_pk_bf16(v0[0], v0[1]); w.y = cvt_pk_bf16(v0[2], v0[3]); w.z = cvt_pk_bf16(v1[0], v1[1]); w.w = cvt_pk_bf16(v1[2], v1[3]);
                        *(u32x4*)(rowp + bj * HALF) = w; } }
        } else {
            const int col0 = (u.pn - 4) * HALF + wc * 32 + 8 * fq;
#pragma unroll
            for (int ai = 0; ai < 2; ++ai)
#pragma unroll
                for (int m = 0; m < 4; ++m) { bf16_t* p = U + (size_t)(row0 + ai * HALF + m * 16) * 1024 + col0;
                    const f32x4 v0 = acc[ai][0][m][0] * acc[ai][1][m][0], v1 = acc[ai][0][m][1] * acc[ai][1][m][1];
                    u32x4 w; w.x = cvt_pk_bf16(v0[0], v0[1]); w.y = cvt_pk_bf16(v0[2], v0[3]); w.z = cvt_pk_bf16(v1[0], v1[1]); w.w = cvt_pk_bf16(v1[2], v1[3]);
                    *(u32x4*)p = w; }
        }
    }
};

template <class Epi, class Sched, bool ALIGN_EPI = false, bool SP2 = false>
__device__ __forceinline__ void gemm_phase(PG8_LAS unsigned char* lds, const Gemm g, const Sched& S, const Epi& E) {
    int tid = threadIdx.x; asm volatile("" : "+v"(tid)); const int wid = __builtin_amdgcn_readfirstlane(tid >> 6), lane = tid & 63, wr = wid >> 2, wc = wid & 3, fr = lane & 15, fq = lane >> 4;
    const int K = g.K, nt = K / BK;
    unsigned voffA[2], voffB[2];
#pragma unroll
    for (int i = 0; i < 2; ++i) { int R, C; stage_rc(tid * 16 + i * 8192, R, C); const int Rb = Epi::PERM ? ((R & ~31) + perm32(R & 31)) : R;
        voffA[i] = (unsigned)(R * K + C) * 2u; voffB[i] = (unsigned)(Rb * K + C) * 2u; }
    const size_t kstep = (size_t)(BK * 2);
    const size_t hstep = (size_t)HALF * K * 2;
    const size_t tstep = 2 * hstep;
    const unsigned ldsw = (unsigned)wid * 1024u;
    const int aoff = lds_byte(wr * 64 + fr, fq * 8), boff = lds_byte(wc * 32 + fr, fq * 8);
#define PG8_SA(b, h) (((b) * 2 + (h)) * HTB)
#define PG8_SB(b, h) ((4 + (b) * 2 + (h)) * HTB)
#define PG8_STAGE(bufoff, gbase, voff) do { _Pragma("unroll") for (int _i = 0; _i < 2; ++_i) \
        __builtin_amdgcn_global_load_lds((const unsigned*)((const char*)(gbase) + (voff)[_i]), (PG8_LAS unsigned*)(lds + (bufoff) + ldsw + _i * 8192), 16, 0, 0); } while (0)
#define PG8_LDA(dst, b, h) do { _Pragma("unroll") for (int m = 0; m < 4; ++m) _Pragma("unroll") for (int k = 0; k < 2; ++k) dst[m][k] = *(const PG8_LAS bf16x8*)(lds + PG8_SA(b, h) + aoff + m * 2048 + k * 1024); } while (0)
#define PG8_LDB(dst, b, h) do { _Pragma("unroll") for (int n = 0; n < 2; ++n) _Pragma("unroll") for (int k = 0; k < 2; ++k) dst[n][k] = *(const PG8_LAS bf16x8*)(lds + PG8_SB(b, h) + boff + n * 2048 + k * 1024); } while (0)
#define PG8_MMA(ai, bj, At, Bt) do { __builtin_amdgcn_s_setprio(1); _Pragma("unroll") for (int m = 0; m < 4; ++m) _Pragma("unroll") for (int n = 0; n < 2; ++n) _Pragma("unroll") for (int k = 0; k < 2; ++k) \
        acc[ai][bj][m][n] = __builtin_amdgcn_mfma_f32_16x16x32_bf16(Bt[n][k], At[m][k], acc[ai][bj][m][n], 0, 0, 0); __builtin_amdgcn_s_setprio(0); } while (0)
#define PG8_WAIT_V(n) asm volatile("s_waitcnt vmcnt(" #n ")" ::: "memory")
#define PG8_WAIT_L(n) asm volatile("s_waitcnt lgkmcnt(" #n ")" ::: "memory")
#define PG8_BAR __builtin_amdgcn_s_barrier()
#define PG8_SCHED __builtin_amdgcn_sched_barrier(0)
    Unit cur, nxt; int ui = 0;
    if (!S.next(0, cur)) return;
    f32x4 acc[2][2][4][2];
#pragma unroll
    for (int a = 0; a < 2; ++a)
#pragma unroll
        for (int b = 0; b < 2; ++b)
#pragma unroll
            for (int m = 0; m < 4; ++m)
#pragma unroll
                for (int n = 0; n < 2; ++n) acc[a][b][m][n] = (f32x4){0.f, 0.f, 0.f, 0.f};
    bf16x8 At[4][2], B0[2][2], B1[2][2];
    const char* cA = (const char*)g.A + (size_t)cur.pm * tstep; const char* cB = (const char*)g.Bt + (size_t)cur.pn * tstep;
    S.a_ready(cur);
    if constexpr (SP2) {
        PG8_STAGE(PG8_SB(0, 0), cB, voffB); PG8_STAGE(PG8_SB(0, 1), cB + hstep, voffB); PG8_STAGE(PG8_SA(0, 0), cA, voffA); PG8_STAGE(PG8_SA(0, 1), cA + hstep, voffA);
        if (wr == 1) PG8_BAR;
        PG8_WAIT_V(2); PG8_BAR;
        PG8_STAGE(PG8_SB(1, 0), cB + kstep, voffB); PG8_STAGE(PG8_SA(1, 0), cA + kstep, voffA); PG8_STAGE(PG8_SB(1, 1), cB + hstep + kstep, voffB);
        PG8_WAIT_V(6); PG8_BAR;
    } else {
        PG8_STAGE(PG8_SB(0, 0), cB, voffB); PG8_STAGE(PG8_SA(0, 0), cA, voffA); PG8_STAGE(PG8_SB(0, 1), cB + hstep, voffB); PG8_STAGE(PG8_SA(0, 1), cA + hstep, voffA);
        if (wr == 1) PG8_BAR;
        PG8_WAIT_V(4); PG8_BAR;
        PG8_STAGE(PG8_SB(1, 0), cB + kstep, voffB); PG8_STAGE(PG8_SA(1, 0), cA + kstep, voffA); PG8_STAGE(PG8_SB(1, 1), cB + hstep + kstep, voffB);
        PG8_WAIT_V(6); PG8_BAR;
    }
    for (;;) {
        const bool has_next = S.next(ui + 1, nxt);
        const char* nA = has_next ? (const char*)g.A + (size_t)nxt.pm * tstep : cA; const char* nB = has_next ? (const char*)g.Bt + (size_t)nxt.pn * tstep : cB;
        for (int t = 0; t < nt; t += 2) {
            const bool last = (t == nt - 2);
            const char* a1 = cA + (size_t)(t + 1) * kstep;
            const char* a2 = last ? nA : cA + (size_t)(t + 2) * kstep; const char* b2 = last ? nB : cB + (size_t)(t + 2) * kstep;
            const char* a3 = a2 + kstep; const char* b3 = b2 + kstep;
            if (last && has_next) S.a_ready(nxt);
            if constexpr (SP2) {
            PG8_LDB(B0, 0, 0); PG8_LDB(B1, 0, 1); PG8_SCHED; PG8_LDA(At, 0, 0); PG8_STAGE(PG8_SA(1, 1), a1 + hstep, voffA);
            PG8_WAIT_V(8); PG8_WAIT_L(0); PG8_BAR; PG8_MMA(0, 0, At, B0); PG8_MMA(0, 1, At, B1); PG8_BAR; PG8_SCHED;
            PG8_LDA(At, 0, 1); PG8_STAGE(PG8_SB(0, 0), b2, voffB); PG8_STAGE(PG8_SB(0, 1), b2 + hstep, voffB); PG8_STAGE(PG8_SA(0, 0), a2, voffA);
            PG8_WAIT_V(8); PG8_WAIT_L(0); PG8_BAR; PG8_MMA(1, 0, At, B0); PG8_MMA(1, 1, At, B1); PG8_BAR; PG8_SCHED;
            PG8_LDB(B0, 1, 0); PG8_LDB(B1, 1, 1); PG8_SCHED; PG8_LDA(At, 1, 0); PG8_STAGE(PG8_SA(0, 1), a2 + hstep, voffA);
            PG8_WAIT_V(8); PG8_WAIT_L(0); PG8_BAR; PG8_MMA(0, 0, At, B0); PG8_MMA(0, 1, At, B1); PG8_BAR; PG8_SCHED;
            PG8_LDA(At, 1, 1); PG8_STAGE(PG8_SB(1, 0), b3, voffB); PG8_STAGE(PG8_SB(1, 1), b3 + hstep, voffB); PG8_STAGE(PG8_SA(1, 0), a3, voffA);
            PG8_WAIT_V(8); PG8_WAIT_L(0); PG8_BAR; PG8_MMA(1, 0, At, B0); PG8_MMA(1, 1, At, B1); PG8_BAR; PG8_SCHED;
            } else {
            PG8_LDB(B0, 0, 0); PG8_SCHED; PG8_LDA(At, 0, 0); PG8_STAGE(PG8_SA(1, 1), a1 + hstep, voffA);
            PG8_WAIT_L(8); PG8_BAR; PG8_WAIT_L(0); PG8_MMA(0, 0, At, B0); PG8_BAR; PG8_SCHED;
            PG8_LDB(B1, 0, 1); PG8_STAGE(PG8_SB(0, 0), b2, voffB);
            PG8_BAR; PG8_WAIT_L(0); PG8_MMA(0, 1, At, B1); PG8_BAR;
            PG8_LDA(At, 0, 1); PG8_STAGE(PG8_SA(0, 0), a2, voffA);
            PG8_BAR; PG8_WAIT_L(0); PG8_MMA(1, 0, At, B0); PG8_BAR; PG8_SCHED;
            PG8_STAGE(PG8_SB(0, 1), b2 + hstep, voffB);
            PG8_WAIT_V(6); PG8_BAR; PG8_MMA(1, 1, At, B1); PG8_BAR;
            PG8_LDB(B0, 1, 0); PG8_SCHED; PG8_LDA(At, 1, 0); PG8_STAGE(PG8_SA(0, 1), a2 + hstep, voffA);
            PG8_WAIT_L(8); PG8_BAR; PG8_WAIT_L(0); PG8_MMA(0, 0, At, B0); PG8_BAR; PG8_SCHED;
            PG8_LDB(B1, 1, 1); PG8_STAGE(PG8_SB(1, 0), b3, voffB);
            PG8_BAR; PG8_WAIT_L(0); PG8_MMA(0, 1, At, B1); PG8_BAR;
            PG8_LDA(At, 1, 1); PG8_STAGE(PG8_SA(1, 0), a3, voffA);
            PG8_BAR; PG8_WAIT_L(0); PG8_MMA(1, 0, At, B0); PG8_BAR; PG8_SCHED;
            PG8_STAGE(PG8_SB(1, 1), b3 + hstep, voffB);
            PG8_WAIT_V(6); PG8_BAR; PG8_MMA(1, 1, At, B1); PG8_BAR;
            }
        }
        if constexpr (ALIGN_EPI) { if (wr == 0) PG8_BAR; }
        if constexpr (!Epi::AFTER_DRAIN) { E(acc, cur, wr, wc, fr, fq); S.done(cur); }
        if (!has_next) break;
#pragma unroll
        for (int a = 0; a < 2; ++a)
#pragma unroll
            for (int b = 0; b < 2; ++b)
#pragma unroll
                for (int m = 0; m < 4; ++m)
#pragma unroll
                    for (int n = 0; n < 2; ++n) acc[a][b][m][n] = (f32x4){0.f, 0.f, 0.f, 0.f};
        cur = nxt; cA = nA; cB = nB; ++ui;
        if constexpr (ALIGN_EPI) { if (wr == 1) PG8_BAR; }
    }
    PG8_WAIT_V(0);
    if constexpr (!ALIGN_EPI) { if (wr == 0) PG8_BAR; }
    PG8_BAR;
    if constexpr (Epi::AFTER_DRAIN) { E.fused(acc, cur, wr, wc, fr, fq, lds, wid, lane); S.done(cur); }
#undef PG8_SA
#undef PG8_SB
#undef PG8_STAGE
#undef PG8_LDA
#undef PG8_LDB
#undef PG8_MMA
#undef PG8_WAIT_V
#undef PG8_WAIT_L
#undef PG8_BAR
#undef PG8_SCHED
}
}

constexpr int DM = 1024, NB = 16, SEQ = 2048, DEPTH = 4, M = NB * SEQ, DFF = 2816, NFF = 2 * DFF;
constexpr int AB_N = 3600, AB_NP = 3840, SC_N = 3072;
constexpr float LN_EPS = 1e-5f;
constexpr float DN_ALPHA = 1.681792830507429f;
constexpr int NWAVES = 8, NT = NWAVES * 64;
constexpr int LDS_BYTES = 147456;
#ifndef M3_SHIFT
#define M3_SHIFT 0
#endif
#ifndef N_SL_DEF
#define N_SL_DEF 12
#endif
constexpr int N_SL = N_SL_DEF;

constexpr size_t MiB = 1u << 20;
constexpr size_t SZ_WFI = (size_t)NFF * DM * 2, SZ_WFO = (size_t)DM * DFF * 2, SZ_WAI = (size_t)AB_NP * DM * 2, SZ_WSQ = (size_t)DM * DM * 2, SZ_WSI = (size_t)SC_N * DM * 2;
constexpr size_t WS_WFI = 1 * MiB;
constexpr size_t WS_WFO = WS_WFI + 8 * SZ_WFI;
constexpr size_t WS_WAI = WS_WFO + 8 * SZ_WFO;
constexpr size_t WS_WAO = WS_WAI + 2 * SZ_WAI;
constexpr size_t WS_WSI = WS_WAO + 2 * SZ_WSQ;
constexpr size_t WS_WSO = WS_WSI + 2 * SZ_WSI;
constexpr size_t WS_XN = WS_WSO + 2 * SZ_WSQ;
constexpr size_t WS_MIX = WS_XN + (size_t)M * DM * 2;
constexpr size_t WS_BIG = WS_MIX + (size_t)M * DM * 2;
constexpr size_t WS_GATES = WS_BIG + (size_t)M * AB_NP * 2;
constexpr size_t WS_DC = WS_GATES + (size_t)M * 16 * 4;
constexpr size_t WS_DN = WS_DC + (size_t)4096 * 16384 * 2;
constexpr size_t WS_SC = WS_DN + (size_t)4096 * 128 * 4;
constexpr size_t WS_MS = WS_SC + (size_t)4096 * 32 * 4;
constexpr size_t WS_END = WS_MS + (size_t)4096 * 4;
static_assert(WS_END <= (size_t)738197504, "workspace map exceeds the guaranteed size");
static_assert(WS_WFI % 256 == 0 && WS_XN % 256 == 0 && WS_BIG % 256 == 0 && WS_DC % 256 == 0, "alignment");

#define LAS __attribute__((address_space(3)))
typedef unsigned short bf16;
typedef unsigned v4u __attribute__((ext_vector_type(4)));
typedef unsigned v2u __attribute__((ext_vector_type(2)));
typedef float f32x4 __attribute__((ext_vector_type(4)));
typedef short bf16x8 __attribute__((ext_vector_type(8)));
#define MFMA16(a, b, c) __builtin_amdgcn_mfma_f32_16x16x32_bf16((a), (b), (c), 0, 0, 0)

__device__ __forceinline__ float bf2f(unsigned short h) { return __builtin_bit_cast(float, (unsigned)h << 16); }
__device__ __forceinline__ float bflo(unsigned w) { return __builtin_bit_cast(float, w << 16); }
__device__ __forceinline__ float bfhi(unsigned w) { return __builtin_bit_cast(float, w & 0xffff0000u); }
__device__ __forceinline__ unsigned pk2(float lo, float hi) { return pg8::cvt_pk_bf16(lo, hi); }
__device__ __forceinline__ float wave_sum(float v) {
#pragma unroll
    for (int o = 1; o < 64; o <<= 1) v += __shfl_xor(v, o);
    return v;
}
__device__ __forceinline__ float wave_max(float v) {
#pragma unroll
    for (int o = 1; o < 64; o <<= 1) v = fmaxf(v, __shfl_xor(v, o));
    return v;
}
__device__ __forceinline__ float scan_sum(float x, int lane, int rev) {
#pragma unroll
    for (int o = 1; o < 64; o <<= 1) { const float up = __shfl_up(x, o), dn = __shfl_down(x, o); const bool ok = rev ? (lane + o < 64) : (lane >= o); const float t = rev ? dn : up; if (ok) x += t; }
    return x;
}
__device__ __forceinline__ float scan_max(float x, int lane, int rev) {
#pragma unroll
    for (int o = 1; o < 64; o <<= 1) { const float up = __shfl_up(x, o), dn = __shfl_down(x, o); const bool ok = rev ? (lane + o < 64) : (lane >= o); const float t = rev ? dn : up; if (ok) x = fmaxf(x, t); }
    return x;
}
__device__ __forceinline__ float log_sigmoid(float x) { return fminf(x, 0.f) - log1pf(__expf(-fabsf(x))); }

__device__ __forceinline__ int map_row(int mode, int n) {
    if (mode == 1) { const int up = n >= DFF ? 1 : 0, i = n - up * DFF; return 256 * (i >> 7) + 128 * up + (i & 127); }
    if (mode == 3) { if (n < 1024) return n; const int q = n - 1024, part = q >> 10, i = q & 1023; return 1024 + 256 * (i >> 7) + 128 * part + (i & 127); }
    return n;
}
__device__ __forceinline__ void transpose_item(const float* W, int K, int N, bf16* WT, int mode, LAS float* scr, int item, int lane) {
    const int nblk = (N + 31) >> 5, kb = item / nblk, nb = item - kb * nblk, k0 = 64 * kb, n0 = 32 * nb;
    const int nl = n0 + (lane & 31); const bool nok = nl < N;
    float cs = 1.0f;
    if (mode == 2) { if (nl < 512) cs = 0.125f; else if (nl >= 2048 && nl < 2560) cs = 0.08838834764831845f; }
#pragma unroll 8
    for (int i = 0; i < 32; ++i) { const int kk = 2 * i + (lane >> 5); scr[kk * 33 + (lane & 31)] = nok ? W[(size_t)(k0 + kk) * N + nl] * cs : 0.f; }
    asm volatile("s_waitcnt lgkmcnt(0)" ::: "memory");
    const int c = lane & 7; const int r0 = map_row(mode, n0);
#pragma unroll
    for (int j = 0; j < 4; ++j) { const int n = (lane >> 3) + 8 * j; const LAS float* s = scr + (8 * c) * 33 + n;
        v4u o; o.x = pk2(s[0 * 33], s[1 * 33]); o.y = pk2(s[2 * 33], s[3 * 33]); o.z = pk2(s[4 * 33], s[5 * 33]); o.w = pk2(s[6 * 33], s[7 * 33]);
        *(v4u*)(WT + (size_t)(r0 + n) * K + k0 + 8 * c) = o; }
    asm volatile("s_waitcnt lgkmcnt(0)" ::: "memory");
}
__device__ __forceinline__ void convert_group(const float* W, int nmats, int K, int N, int NP, bf16* WT, int mode, LAS float* scr, int gw, int NGW, int lane) {
    const int per = (K >> 6) * ((N + 31) >> 5), tot = nmats * per;
    for (int it = gw; it < tot; it += NGW) { const int mt = it / per, r = it - mt * per; transpose_item(W + (size_t)mt * K * N, K, N, WT + (size_t)mt * NP * K, mode, scr, r, lane); }
}

__device__ __forceinline__ void ln_phase(float* Y, bf16* XN, const float* g, const float* b, int gw, int NGW, int lane) {
    for (int m = gw; m < M; m += NGW) {
        f32x4* yr = (f32x4*)(Y + (size_t)m * DM) + lane;
        f32x4 v[4]; float s = 0.f;
#pragma unroll
        for (int j = 0; j < 4; ++j) { v[j] = yr[64 * j]; s += (v[j].x + v[j].y) + (v[j].z + v[j].w); }
        const float mean = wave_sum(s) * (1.f / DM); float s2 = 0.f;
#pragma unroll
        for (int j = 0; j < 4; ++j) { v[j] = v[j] - mean; s2 += (v[j].x * v[j].x + v[j].y * v[j].y) + (v[j].z * v[j].z + v[j].w * v[j].w); }
        const float rstd = 1.f / sqrtf(wave_sum(s2) * (1.f / DM) + LN_EPS);
        v2u* o8 = (v2u*)(XN + (size_t)m * DM) + lane;
#pragma unroll
        for (int j = 0; j < 4; ++j) { const f32x4 gg = ((const f32x4*)g)[lane + 64 * j], bb = ((const f32x4*)b)[lane + 64 * j]; const f32x4 o = v[j] * rstd * gg + bb;
            yr[64 * j] = o; v2u w; w.x = pk2(o.x, o.y); w.y = pk2(o.z, o.w); o8[64 * j] = w; }
    }
}
__device__ __forceinline__ void copy_phase(const float* X, float* Y, bf16* XN, int gw, int NGW, int lane) {
    for (int m = gw; m < M; m += NGW) {
        const f32x4* xr = (const f32x4*)(X + (size_t)m * DM) + lane; f32x4* yr = (f32x4*)(Y + (size_t)m * DM) + lane; v2u* o8 = (v2u*)(XN + (size_t)m * DM) + lane;
#pragma unroll
        for (int j = 0; j < 4; ++j) { const f32x4 o = xr[64 * j]; yr[64 * j] = o; v2u w; w.x = pk2(o.x, o.y); w.y = pk2(o.z, o.w); o8[64 * j] = w; }
    }
}

__device__ __forceinline__ void na_phase(LAS unsigned char* lds, const bf16* AB, const float* rpb, bf16* MIX, int bid, int G, int tid) {
    const int lane = tid & 63, wave = tid >> 6, fr = lane & 15, fq = lane >> 4;
    constexpr int VP = 144;
    LAS unsigned char* Vs = lds;
    LAS float* Rp = (LAS float*)(lds + 9 * 64 * VP);
    for (int item = bid; item < NB * 8 * 16; item += G) {
        const int rp = item & 15, h = (item >> 4) & 7, b = item >> 7;
        const int r0 = 2 * rp; const int rsA = min(max(r0 - 4, 0), 24);
        __syncthreads();
        for (int ch = tid; ch < 9 * 64 * 8; ch += NT) { const int key = ch >> 3, c8 = ch & 7; const int row = rsA + (key >> 6);
            if (row < 32) { const v4u val = *(const v4u*)(AB + (size_t)(b * SEQ + row * 64 + (key & 63)) * AB_NP + 1024 + 64 * h + 8 * c8); *(LAS v4u*)(Vs + key * VP + c8 * 16) = val; } }
        for (int i = tid; i < 465; i += NT) Rp[i] = rpb[h * 465 + i];
        __syncthreads();
        const int j = wave & 3, r = r0 + (wave >> 2);
        const int rs = min(max(r - 4, 0), 24);
        const int kbs = min(max(16 * j - 8, 0), 32);
        const size_t tokq = (size_t)b * SEQ + r * 64 + 16 * j + fr;
        bf16x8 qop[2];
#pragma unroll
        for (int kb = 0; kb < 2; ++kb) qop[kb] = *(const bf16x8*)(AB + tokq * AB_NP + 64 * h + 32 * kb + 8 * fq);
        f32x4 s[16];
#pragma unroll
        for (int t = 0; t < 16; ++t) { const int kr = t >> 1, chh = t & 1; const size_t tokk = (size_t)b * SEQ + (rs + kr) * 64 + kbs + 16 * chh + fr;
            const bf16* kp = AB + tokk * AB_NP + 512 + 64 * h + 8 * fq; const bf16x8 k0 = *(const bf16x8*)kp, k1 = *(const bf16x8*)(kp + 32);
            f32x4 a = (f32x4){0.f, 0.f, 0.f, 0.f}; a = MFMA16(k0, qop[0], a); a = MFMA16(k1, qop[1], a); s[t] = a; }
        const int qc = 16 * j + fr; const int cs = min(max(qc - 8, 0), 48);
        float mx = -INFINITY;
#pragma unroll
        for (int t = 0; t < 16; ++t) { const int kr = t >> 1, chh = t & 1; const int dr = rs + kr - r + 7;
#pragma unroll
            for (int jj = 0; jj < 4; ++jj) { const int kc = kbs + 16 * chh + 4 * fq + jj; const bool ok = (kc >= cs) && (kc < cs + 16); const int dc = min(max(kc - qc + 15, 0), 30);
                const float v = ok ? s[t][jj] + Rp[dr * 31 + dc] : -INFINITY; s[t][jj] = v; mx = fmaxf(mx, v); } }
        mx = fmaxf(mx, __shfl_xor(mx, 16)); mx = fmaxf(mx, __shfl_xor(mx, 32));
        float l = 0.f;
#pragma unroll
        for (int t = 0; t < 16; ++t)
#pragma unroll
            for (int jj = 0; jj < 4; ++jj) { const float p = __expf(s[t][jj] - mx); l += p; s[t][jj] = p; }
        l += __shfl_xor(l, 16); l += __shfl_xor(l, 32);
        f32x4 o[4];
#pragma unroll
        for (int dt = 0; dt < 4; ++dt) o[dt] = (f32x4){0.f, 0.f, 0.f, 0.f};
        const int lr0 = rs - rsA;
#pragma unroll
        for (int kk = 0; kk < 8; ++kk) {
            v4u pw; pw.x = pk2(s[2 * kk][0], s[2 * kk][1]); pw.y = pk2(s[2 * kk][2], s[2 * kk][3]); pw.z = pk2(s[2 * kk + 1][0], s[2 * kk + 1][1]); pw.w = pk2(s[2 * kk + 1][2], s[2 * kk + 1][3]);
            const bf16x8 pop = __builtin_bit_cast(bf16x8, pw);
            const LAS unsigned char* vb = Vs + ((lr0 + kk) * 64 + kbs + 4 * fq) * VP + fr * 2;
#pragma unroll
            for (int dt = 0; dt < 4; ++dt) { bf16x8 vop;
#pragma unroll
                for (int i = 0; i < 8; ++i) vop[i] = (short)*(const LAS unsigned short*)(vb + ((i < 4 ? i : 12 + i)) * VP + dt * 32);
                o[dt] = MFMA16(pop, vop, o[dt]); }
        }
#pragma unroll
        for (int jj = 0; jj < 4; ++jj) { const float linv = 1.0f / __shfl(l, 4 * fq + jj); const size_t tok = (size_t)b * SEQ + r * 64 + 16 * j + 4 * fq + jj;
#pragma unroll
            for (int dt = 0; dt < 4; ++dt) MIX[tok * DM + 64 * h + 16 * dt + fr] = (bf16)(pk2(o[dt][jj] * linv, 0.f) & 0xffffu); }
    }
}

constexpr int CP = 272;
__device__ __forceinline__ void m1_phase(LAS unsigned char* lds, const bf16* AB, const float* GATES, const float* gate_b, bf16* DC, float* DN, float* SC, int bid, int G, int tid) {
    const int lane = tid & 63, wave = tid >> 6, fr = lane & 15, fq = lane >> 4;
    LAS unsigned char* Ks = lds; LAS unsigned char* Vs = lds + 64 * CP; LAS float* was = (LAS float*)(lds + 2 * 64 * CP);
    for (int item = bid; item < 4096; item += G) {
        const int c = item & 31, dir = (item >> 5) & 1, hh = (item >> 6) & 3, b = item >> 8;
        const size_t tok0 = (size_t)b * SEQ + 64 * c;
        __syncthreads();
        for (int ch = tid; ch < 2048; ch += NT) { const int mat = ch >> 10, row = (ch >> 4) & 63, c16 = ch & 15;
            const v4u val = *(const v4u*)(AB + (tok0 + row) * AB_NP + 2048 + 512 * mat + 128 * hh + 8 * c16); *(LAS v4u*)((mat ? Vs : Ks) + row * CP + c16 * 16) = val; }
        {
            const size_t tok = tok0 + lane;
            const float gi = GATES[tok * 16 + 8 * dir + hh] + gate_b[8 * dir + hh], gf = GATES[tok * 16 + 8 * dir + 4 + hh] + gate_b[8 * dir + 4 + hh];
            const float lf = log_sigmoid(gf); const float bcs = scan_sum(lf, lane, dir); const float g = __shfl(bcs, dir ? 0 : 63);
            const float a = g - bcs + gi; const float ml = wave_max(a); const float wa = __expf(a - ml);
            if (wave == 0) { was[lane] = wa; if (lane == 0) { SC[32 * item] = g; SC[32 * item + 1] = ml; } }
        }
        __syncthreads();
        if (tid < 128) { float acc = 0.f;
#pragma unroll 8
            for (int s = 0; s < 64; ++s) acc += was[s] * bf2f(*(const LAS unsigned short*)(Ks + s * CP + tid * 2));
            DN[(size_t)item * 128 + tid] = acc; }
        bf16x8 vop[2];
#pragma unroll
        for (int kb = 0; kb < 2; ++kb) { float t[8];
#pragma unroll
            for (int i = 0; i < 8; ++i) { const int s = 32 * kb + 8 * fq + i; t[i] = was[s] * bf2f(*(const LAS unsigned short*)(Vs + s * CP + (16 * wave + fr) * 2)); }
            v4u w; w.x = pk2(t[0], t[1]); w.y = pk2(t[2], t[3]); w.z = pk2(t[4], t[5]); w.w = pk2(t[6], t[7]); vop[kb] = __builtin_bit_cast(bf16x8, w); }
        bf16* dcp = DC + (size_t)item * 16384 + (size_t)(16 * wave + fr) * 128 + 4 * fq;
#pragma unroll
        for (int nt = 0; nt < 8; ++nt) { f32x4 acc = (f32x4){0.f, 0.f, 0.f, 0.f};
#pragma unroll
            for (int kb = 0; kb < 2; ++kb) { bf16x8 kop;
#pragma unroll
                for (int i = 0; i < 8; ++i) kop[i] = (short)*(const LAS unsigned short*)(Ks + (32 * kb + 8 * fq + i) * CP + (16 * nt + fr) * 2);
                acc = MFMA16(kop, vop[kb], acc); }
            v2u w; w.x = pk2(acc[0], acc[1]); w.y = pk2(acc[2], acc[3]); *(v2u*)(dcp + 16 * nt) = w; }
    }
}
__device__ __forceinline__ void m2_phase(bf16* DC, float* DN, const float* SC, float* MS, int bid, int G, int tid) {
    for (int gidx = bid * NT + tid; gidx < 128 * 2048; gidx += G * NT) {
        const int seq = gidx >> 11, e8 = gidx & 2047, dir = seq & 1;
        float C0 = 0.f, C1 = 0.f, C2 = 0.f, C3 = 0.f, C4 = 0.f, C5 = 0.f, C6 = 0.f, C7 = 0.f, m = 0.f;
        v4u* base = (v4u*)(DC + (size_t)seq * 32 * 16384 + (size_t)e8 * 8);
#pragma unroll 1
        for (int s0 = 0; s0 < 32; s0 += 8) {
            v4u raw[8]; float gg[8], mll[8];
#pragma unroll
            for (int u = 0; u < 8; ++u) { const int c = dir ? 31 - (s0 + u) : (s0 + u); raw[u] = base[(size_t)c * 2048]; gg[u] = SC[32 * (seq * 32 + c)]; mll[u] = SC[32 * (seq * 32 + c) + 1]; }
#pragma unroll
            for (int u = 0; u < 8; ++u) { const int c = dir ? 31 - (s0 + u) : (s0 + u);
                v4u o; o.x = pk2(C0, C1); o.y = pk2(C2, C3); o.z = pk2(C4, C5); o.w = pk2(C6, C7); base[(size_t)c * 2048] = o;
                if (e8 == 0) MS[seq * 32 + c] = m;
                const float mn = fmaxf(gg[u] + m, mll[u]); const float dec = __expf(gg[u] + m - mn), sc = __expf(mll[u] - mn);
                C0 = dec * C0 + sc * bflo(raw[u].x); C1 = dec * C1 + sc * bfhi(raw[u].x); C2 = dec * C2 + sc * bflo(raw[u].y); C3 = dec * C3 + sc * bfhi(raw[u].y);
                C4 = dec * C4 + sc * bflo(raw[u].z); C5 = dec * C5 + sc * bfhi(raw[u].z); C6 = dec * C6 + sc * bflo(raw[u].w); C7 = dec * C7 + sc * bfhi(raw[u].w);
                m = mn; }
        }
    }
    for (int gidx = bid * NT + tid; gidx < 128 * 128; gidx += G * NT) {
        const int seq = gidx >> 7, kd = gidx & 127, dir = seq & 1;
        float n = 0.f, m = 0.f;
        float* base = DN + (size_t)seq * 32 * 128 + kd;
#pragma unroll 1
        for (int s0 = 0; s0 < 32; s0 += 8) {
            float raw[8], gg[8], mll[8];
#pragma unroll
            for (int u = 0; u < 8; ++u) { const int c = dir ? 31 - (s0 + u) : (s0 + u); raw[u] = base[c * 128]; gg[u] = SC[32 * (seq * 32 + c)]; mll[u] = SC[32 * (seq * 32 + c) + 1]; }
#pragma unroll
            for (int u = 0; u < 8; ++u) { const int c = dir ? 31 - (s0 + u) : (s0 + u);
                base[c * 128] = n;
                const float mn = fmaxf(gg[u] + m, mll[u]); const float dec = __expf(gg[u] + m - mn), sc = __expf(mll[u] - mn);
                n = dec * n + sc * raw[u]; m = mn; }
        }
    }
}
__device__ __forceinline__ void m3_phase(LAS unsigned char* lds, const bf16* AB, const float* GATES, const float* gate_b, const bf16* CPV, const float* NP, const float* MS,
                                         const float* gn_g, bf16* MIX, int bid, int G, int tid) {
    const int lane = tid & 63, wave = tid >> 6, fr = lane & 15, fq = lane >> 4;
    constexpr int PP = 144;
    LAS unsigned char* Qs = lds; LAS unsigned char* Ks = lds + 64 * CP; LAS unsigned char* Vs = lds + 2 * 64 * CP; LAS unsigned char* Ps = lds + 3 * 64 * CP;
    LAS float* sb = (LAS float*)(lds + 3 * 64 * CP + 64 * PP); LAS float* su = sb + 64; LAS float* sint = su + 64; LAS float* sen = sint + 64; LAS float* sscale = sen + 64;
    LAS float* npv = sscale + 64; LAS float* part = npv + 128;
    for (int item = (bid + M3_SHIFT) % G; item < 2048; item += G) {
        const int c = item & 31, hh = (item >> 5) & 3, b = item >> 7;
        const size_t tok0 = (size_t)b * SEQ + 64 * c;
        __syncthreads();
        for (int ch = tid; ch < 3072; ch += NT) { const int mat = ch >> 10, row = (ch >> 4) & 63, c16 = ch & 15;
            const v4u val = *(const v4u*)(AB + (tok0 + row) * AB_NP + 1536 + 512 * mat + 128 * hh + 8 * c16); *(LAS v4u*)(lds + mat * 64 * CP + row * CP + c16 * 16) = val; }
        f32x4 hsum[4];
#pragma unroll
        for (int tt = 0; tt < 4; ++tt) hsum[tt] = (f32x4){0.f, 0.f, 0.f, 0.f};
#pragma unroll 1
        for (int dir = 0; dir < 2; ++dir) {
            const int it2 = ((b * 4 + hh) * 2 + dir) * 32 + c;
            {
                const size_t tok = tok0 + lane;
                const float gi = GATES[tok * 16 + 8 * dir + hh] + gate_b[8 * dir + hh], gf = GATES[tok * 16 + 8 * dir + 4 + hh] + gate_b[8 * dir + 4 + hh];
                const float lf = log_sigmoid(gf); const float bcs = scan_sum(lf, lane, dir); const float mprev = MS[it2];
                const float inter = bcs + mprev; const float uu = gi - bcs; const float pm = scan_max(uu, lane, dir); const float mt = fmaxf(inter, bcs + pm);
                if (wave == 0) { sb[lane] = bcs - mt; su[lane] = uu; sint[lane] = __expf(inter - mt); sen[lane] = __expf(-mt); }
                if (tid >= 64 && tid < 192) npv[tid - 64] = NP[(size_t)it2 * 128 + tid - 64];
            }
            __syncthreads();
            {
                const int tt = wave >> 1;
#pragma unroll
                for (int q2 = 0; q2 < 2; ++q2) { const int st = 2 * (wave & 1) + q2; f32x4 acc = (f32x4){0.f, 0.f, 0.f, 0.f};
#pragma unroll
                    for (int kb = 0; kb < 4; ++kb) { const bf16x8 qop = *(const LAS bf16x8*)(Qs + (16 * tt + fr) * CP + (32 * kb + 8 * fq) * 2); const bf16x8 kop = *(const LAS bf16x8*)(Ks + (16 * st + fr) * CP + (32 * kb + 8 * fq) * 2);
                        acc = MFMA16(qop, kop, acc); }
                    const int sig = 16 * st + fr; const float usig = su[sig];
#pragma unroll
                    for (int jj = 0; jj < 4; ++jj) { const int tau = 16 * tt + 4 * fq + jj; const bool ok = dir ? (sig >= tau) : (sig <= tau);
                        const float w = ok ? __expf(sb[tau] + usig) : 0.f; const float p = ok ? acc[jj] * w : 0.f;
                        *(LAS unsigned short*)(Ps + tau * PP + sig * 2) = (unsigned short)(pk2(p, 0.f) & 0xffffu); } }
            }
            __syncthreads();
            {
                const int tau = tid >> 3, pt = tid & 7;
                const v4u pv = *(const LAS v4u*)(Ps + tau * PP + pt * 16);
                float dsum = ((bflo(pv.x) + bfhi(pv.x)) + (bflo(pv.y) + bfhi(pv.y))) + ((bflo(pv.z) + bfhi(pv.z)) + (bflo(pv.w) + bfhi(pv.w)));
                float qn = 0.f;
#pragma unroll
                for (int hf = 0; hf < 2; ++hf) { const v4u qv = *(const LAS v4u*)(Qs + tau * CP + (pt * 16 + hf * 8) * 2); const LAS float* np = npv + pt * 16 + hf * 8;
                    qn += bflo(qv.x) * np[0] + bfhi(qv.x) * np[1] + bflo(qv.y) * np[2] + bfhi(qv.y) * np[3] + bflo(qv.z) * np[4] + bfhi(qv.z) * np[5] + bflo(qv.w) * np[6] + bfhi(qv.w) * np[7]; }
                dsum += __shfl_xor(dsum, 1); dsum += __shfl_xor(dsum, 2); dsum += __shfl_xor(dsum, 4);
                qn += __shfl_xor(qn, 1); qn += __shfl_xor(qn, 2); qn += __shfl_xor(qn, 4);
                const float den = dsum + sint[tau] * qn; const float scl = 1.0f / fmaxf(fabsf(den), sen[tau]);
                if (pt == 0) sscale[tau] = scl;
            }
            __syncthreads();
            {
                bf16x8 vop[2], cop[4];
#pragma unroll
                for (int kb = 0; kb < 2; ++kb)
#pragma unroll
                    for (int i = 0; i < 8; ++i) vop[kb][i] = (short)*(const LAS unsigned short*)(Vs + (32 * kb + 8 * fq + i) * CP + (16 * wave + fr) * 2);
                const bf16* cpp = CPV + (size_t)it2 * 16384 + (size_t)(16 * wave + fr) * 128 + 8 * fq;
#pragma unroll
                for (int kb = 0; kb < 4; ++kb) cop[kb] = *(const bf16x8*)(cpp + 32 * kb);
#pragma unroll
                for (int tt = 0; tt < 4; ++tt) { f32x4 ai = (f32x4){0.f, 0.f, 0.f, 0.f}, ae = (f32x4){0.f, 0.f, 0.f, 0.f};
#pragma unroll
                    for (int kb = 0; kb < 2; ++kb) { const bf16x8 pop = *(const LAS bf16x8*)(Ps + (16 * tt + fr) * PP + (32 * kb + 8 * fq) * 2); ai = MFMA16(vop[kb], pop, ai); }
#pragma unroll
                    for (int kb = 0; kb < 4; ++kb) { const bf16x8 qop = *(const LAS bf16x8*)(Qs + (16 * tt + fr) * CP + (32 * kb + 8 * fq) * 2); ae = MFMA16(cop[kb], qop, ae); }
                    const int tau = 16 * tt + fr; const float si = sint[tau], sc = sscale[tau];
                    hsum[tt] += (ai + ae * si) * sc; }
            }
            __syncthreads();
        }
#pragma unroll
        for (int tt = 0; tt < 4; ++tt) { const f32x4 hv = hsum[tt]; float s1 = (hv[0] + hv[1]) + (hv[2] + hv[3]); float s2 = (hv[0] * hv[0] + hv[1] * hv[1]) + (hv[2] * hv[2] + hv[3] * hv[3]);
            s1 += __shfl_xor(s1, 16); s1 += __shfl_xor(s1, 32); s2 += __shfl_xor(s2, 16); s2 += __shfl_xor(s2, 32);
            if (fq == 0) { part[(wave * 64 + 16 * tt + fr) * 2] = s1; part[(wave * 64 + 16 * tt + fr) * 2 + 1] = s2; } }
        __syncthreads();
#pragma unroll
        for (int tt = 0; tt < 4; ++tt) { const int tau = 16 * tt + fr; float S1 = 0.f, S2 = 0.f;
#pragma unroll
            for (int w = 0; w < 8; ++w) { S1 += part[(w * 64 + tau) * 2]; S2 += part[(w * 64 + tau) * 2 + 1]; }
            const float mean = S1 * (1.f / 128.f); const float var = fmaxf(S2 * (1.f / 128.f) - mean * mean, 0.f); const float rstd = 1.0f / sqrtf(var + LN_EPS);
            const size_t tokm = tok0 + tau; const int vc = 128 * hh + 16 * wave + 4 * fq;
            const v2u ob = *(const v2u*)(AB + tokm * AB_NP + 3072 + vc); const f32x4 gn = *(const f32x4*)(gn_g + vc);
            const f32x4 hv = hsum[tt];
            const float o0 = bflo(ob.x), o1 = bfhi(ob.x), o2 = bflo(ob.y), o3 = bfhi(ob.y);
            const float y0 = (hv[0] - mean) * rstd * gn[0] * __builtin_amdgcn_rcpf(1.f + __expf(-o0));
            const float y1 = (hv[1] - mean) * rstd * gn[1] * __builtin_amdgcn_rcpf(1.f + __expf(-o1));
            const float y2 = (hv[2] - mean) * rstd * gn[2] * __builtin_amdgcn_rcpf(1.f + __expf(-o2));
            const float y3 = (hv[3] - mean) * rstd * gn[3] * __builtin_amdgcn_rcpf(1.f + __expf(-o3));
            v2u w; w.x = pk2(y0, y1); w.y = pk2(y2, y3); *(v2u*)(MIX + tokm * DM + 512 + vc) = w; }
    }
}

__device__ __forceinline__ void conv_phase(const bf16* BG, const bf16* U, const float* cw, const float* cb, bf16* MIX, int bid, int G, int tid) {
    for (int idx = bid * NT + tid; idx < M * 128; idx += G * NT) {
        const int m = idx >> 7, c8 = (idx & 127) * 8, s = m & (SEQ - 1);
        const v4u uc = *(const v4u*)(U + (size_t)m * DM + c8);
        v4u up = (v4u){0u, 0u, 0u, 0u}, un = (v4u){0u, 0u, 0u, 0u};
        if (s > 0) up = *(const v4u*)(U + (size_t)(m - 1) * DM + c8);
        if (s < SEQ - 1) un = *(const v4u*)(U + (size_t)(m + 1) * DM + c8);
        const v4u bg = *(const v4u*)(BG + (size_t)m * DM + c8);
        const f32x4 w0a = *(const f32x4*)(cw + c8), w0b = *(const f32x4*)(cw + c8 + 4), w1a = *(const f32x4*)(cw + DM + c8), w1b = *(const f32x4*)(cw + DM + c8 + 4);
        const f32x4 w2a = *(const f32x4*)(cw + 2 * DM + c8), w2b = *(const f32x4*)(cw + 2 * DM + c8 + 4), ba = *(const f32x4*)(cb + c8), bb = *(const f32x4*)(cb + c8 + 4);
        v4u o;
        o.x = pk2(bflo(bg.x) * (w0a[0] * bflo(up.x) + w1a[0] * bflo(uc.x) + w2a[0] * bflo(un.x) + ba[0]), bfhi(bg.x) * (w0a[1] * bfhi(up.x) + w1a[1] * bfhi(uc.x) + w2a[1] * bfhi(un.x) + ba[1]));
        o.y = pk2(bflo(bg.y) * (w0a[2] * bflo(up.y) + w1a[2] * bflo(uc.y) + w2a[2] * bflo(un.y) + ba[2]), bfhi(bg.y) * (w0a[3] * bfhi(up.y) + w1a[3] * bfhi(uc.y) + w2a[3] * bfhi(un.y) + ba[3]));
        o.z = pk2(bflo(bg.z) * (w0b[0] * bflo(up.z) + w1b[0] * bflo(uc.z) + w2b[0] * bflo(un.z) + bb[0]), bfhi(bg.z) * (w0b[1] * bfhi(up.z) + w1b[1] * bfhi(uc.z) + w2b[1] * bfhi(un.z) + bb[1]));
        o.w = pk2(bflo(bg.w) * (w0b[2] * bflo(up.w) + w1b[2] * bflo(uc.w) + w2b[2] * bflo(un.w) + bb[2]), bfhi(bg.w) * (w0b[3] * bfhi(up.w) + w1b[3] * bfhi(uc.w) + w2b[3] * bfhi(un.w) + bb[3]));
        *(v4u*)(MIX + (size_t)m * DM + c8) = o;
    }
}

#define XB_TMO      128
#define XB_XCNT(j)  (256  + 64 * (j))
#define XB_XSUB(j)  (1280 + 64 * (j))
#define XB_XGEN(j)  (2304 + 64 * (j))
#define XB_TOP      3328
#define XB_TOPGEN   3392
#define XCD_BAR_WORDS 3456
#define XB_SPIN_CAP (1u << 18)

__device__ __forceinline__ unsigned xb_ld(unsigned* p)              { return __hip_atomic_load(p, __ATOMIC_RELAXED, __HIP_MEMORY_SCOPE_AGENT); }
__device__ __forceinline__ unsigned xb_add(unsigned* p, unsigned v) { return __hip_atomic_fetch_add(p, v, __ATOMIC_RELAXED, __HIP_MEMORY_SCOPE_AGENT); }
__device__ __forceinline__ unsigned xb_xcc_id() { return (unsigned)__builtin_amdgcn_s_getreg((3 << 11) | 20) & 0xFu; }
#define XB_SPIN(cond, bar) do { unsigned _sp = 0; while (cond) { __builtin_amdgcn_s_sleep(1); \
    if ((++_sp & 255u) == 0u) { if (xb_ld(&(bar)[XB_TMO])) break; if (_sp > XB_SPIN_CAP) { atomicAdd(&(bar)[XB_TMO], 1u); break; } } } } while (0)

struct XcdBarrier {
    unsigned* bar; unsigned x;
    volatile LAS unsigned* st;
};

__device__ __forceinline__ XcdBarrier xcd_barrier_post(unsigned* bar, volatile LAS unsigned* st) {
    XcdBarrier b; b.bar = bar; b.x = xb_xcc_id(); b.st = st;
    if (threadIdx.x == 0) (void)xb_add(&bar[XB_XCNT(b.x)], 1u);
    return b;
}
__device__ __forceinline__ void xcd_barrier_complete(unsigned* bar, unsigned x, unsigned& nloc, unsigned& nx) {
    const unsigned G = gridDim.x * gridDim.y * gridDim.z;
    unsigned sum, cnt, mine, sp = 0u;
    for (;;) {
        sum = 0u; cnt = 0u; mine = 0u;
#pragma unroll
        for (unsigned j = 0; j < 16; ++j) { const unsigned c = xb_ld(&bar[XB_XCNT(j)]); sum += c; cnt += (c > 0u) ? 1u : 0u; mine = (j == x) ? c : mine; }
        if (sum == G) break;
        __builtin_amdgcn_s_sleep(1);
        if ((++sp & 255u) == 0u) { if (xb_ld(&bar[XB_TMO])) break; if (sp > XB_SPIN_CAP) { atomicAdd(&bar[XB_TMO], 1u); break; } }
    }
    nloc = mine > 0u ? mine : 1u; nx = cnt > 0u ? cnt : 1u;
}

__device__ __forceinline__ void xcd_barrier(const XcdBarrier& b) {
    asm volatile("s_waitcnt vmcnt(0)" ::: "memory");
    __syncthreads();
    if (threadIdx.x == 0) {
        unsigned* bar = b.bar;
        __builtin_amdgcn_s_waitcnt(0);
        unsigned nloc = b.st[0], nx = b.st[1];
        if (nloc == 0u) { xcd_barrier_complete(bar, b.x, nloc, nx); b.st[0] = nloc; b.st[1] = nx; }
        const unsigned old = xb_add(&bar[XB_XSUB(b.x)], 1u);
        const unsigned gen = old / nloc;
        if (old + 1u == (gen + 1u) * nloc) {
            __builtin_amdgcn_fence(__ATOMIC_RELEASE, "agent");
            asm volatile("s_waitcnt vmcnt(0)" ::: "memory");
            const unsigned og = xb_add(&bar[XB_TOP], 1u);
            const unsigned tg = og / nx;
            if (og + 1u == (tg + 1u) * nx) xb_add(&bar[XB_TOPGEN], 1u);
            else XB_SPIN(xb_ld(&bar[XB_TOPGEN]) == tg, bar);
            __builtin_amdgcn_fence(__ATOMIC_ACQUIRE, "agent");
            xb_add(&bar[XB_XGEN(b.x)], 1u);
            asm volatile("s_waitcnt vmcnt(0)" ::: "memory");
        } else {
            XB_SPIN(xb_ld(&bar[XB_XGEN(b.x)]) == gen, bar);
            __builtin_amdgcn_fence(__ATOMIC_ACQUIRE, "agent");
            asm volatile("s_waitcnt vmcnt(0)" ::: "memory");
        }
    }
    __syncthreads();
}

struct Args { const float* in[14]; float* out; unsigned char* ws; };
#define GRID_SYNC_RAW() do { asm volatile("s_waitcnt vmcnt(0) lgkmcnt(0)" ::: "memory"); __syncthreads(); grid.sync(); __builtin_amdgcn_fence(__ATOMIC_ACQUIRE, "agent"); asm volatile("s_waitcnt vmcnt(0)" ::: "memory"); __syncthreads(); } while (0)
#ifdef TMASK_A
#define TS(cat) do { const unsigned long long n_ = __builtin_amdgcn_s_memrealtime(); const float d_ = (float)(n_ - t_prev) * 0.01f; if ((TMASK_A >> (cat)) & 1) accA += d_; if ((TMASK_B >> (cat)) & 1) accB += d_; t_prev = n_; } while (0)
#else
#define TS(cat) do { } while (0)
#endif
#define GRID_SYNC_CG() do { GRID_SYNC_RAW(); TS(11); } while (0)
#define GRID_SYNC() do { xcd_barrier(xbar); TS(11); } while (0)
__device__ __forceinline__ int opaque_tid() { int t = threadIdx.x; asm volatile("" : "+v"(t)); return t; }
__global__ void __launch_bounds__(NT, 2) fwd_megakernel(Args args) {
    extern __shared__ __attribute__((aligned(16))) unsigned char lds_raw[];
    cg::grid_group grid = cg::this_grid();
    LAS unsigned char* lds = (LAS unsigned char*)lds_raw;
    const int G = gridDim.x, bid = blockIdx.x;
    { const int t0_ = threadIdx.x; if (t0_ < 128) ((LAS unsigned*)(lds + 131072))[t0_] = 0u; }
    __syncthreads();
    if (bid == 0) { for (int i = threadIdx.x; i < XCD_BAR_WORDS; i += NT) __hip_atomic_store((unsigned*)args.ws + 4096 + i, 0u, __ATOMIC_RELAXED, __HIP_MEMORY_SCOPE_AGENT); }
#ifdef TMASK_A
    unsigned long long t_prev = __builtin_amdgcn_s_memrealtime(); float accA = 0.f, accB = 0.f;
#endif

    {
        const int tid = opaque_tid(), lane = tid & 63, wave = tid >> 6; const int gw = bid * NWAVES + wave, NGW = G * NWAVES;
        unsigned char* ws = args.ws;
        LAS float* scr = (LAS float*)(lds + wave * 16384);
        convert_group(args.in[3], 8, DM, NFF, NFF, (bf16*)(ws + WS_WFI), 1, scr, gw, NGW, lane);
        convert_group(args.in[4], 8, DFF, DM, DM, (bf16*)(ws + WS_WFO), 0, scr, gw, NGW, lane);
        convert_group(args.in[5], 2, DM, AB_N, AB_NP, (bf16*)(ws + WS_WAI), 2, scr, gw, NGW, lane);
        convert_group(args.in[9], 2, DM, DM, DM, (bf16*)(ws + WS_WAO), 0, scr, gw, NGW, lane);
        convert_group(args.in[10], 2, DM, SC_N, SC_N, (bf16*)(ws + WS_WSI), 3, scr, gw, NGW, lane);
        convert_group(args.in[13], 2, DM, DM, DM, (bf16*)(ws + WS_WSO), 0, scr, gw, NGW, lane);
        copy_phase(args.in[0], args.out, (bf16*)(ws + WS_XN), gw, NGW, lane);
    }
    TS(0);
    GRID_SYNC_CG();
    const XcdBarrier xbar = xcd_barrier_post((unsigned*)args.ws + 4096, (volatile LAS unsigned*)(lds + 131072 + 352));

#pragma unroll 1
    for (int sl = 0; sl < N_SL; ++sl) {
        const int layer = sl / 3, sub = sl - 3 * layer;
        unsigned char* ws = args.ws; asm volatile("" : "+s"(ws));
        float* Y = args.out;
        bf16* XN = (bf16*)(ws + WS_XN); bf16* MIX = (bf16*)(ws + WS_MIX); bf16* BIG = (bf16*)(ws + WS_BIG);
        const bf16* A2; const bf16* B2; int K2; float scale2;
        if (sub != 1) {
            const int j = sub >> 1;
            pg8::Gemm g{XN, (const bf16*)(ws + WS_WFI) + (size_t)(layer * 2 + j) * NFF * DM, M, NFF, DM}; pg8::StaticOrder S; S.init(M, NFF, G, bid);
            pg8::EpiSwiGLU E{BIG, DFF};
            pg8::gemm_phase<pg8::EpiSwiGLU, pg8::StaticOrder, true, true>(lds, g, S, E); TS(1);
#ifdef GEMM_TWICE
            pg8::gemm_phase<pg8::EpiSwiGLU, pg8::StaticOrder, true, true>(lds, g, S, E);
#endif
            A2 = BIG; B2 = (const bf16*)(ws + WS_WFO) + (size_t)(layer * 2 + j) * DM * DFF; K2 = DFF; scale2 = 0.5f;
            GRID_SYNC();
        } else if ((layer & 1) == 0) {
            const int e = layer >> 1;
            float* GATES = (float*)(ws + WS_GATES); bf16* DC = (bf16*)(ws + WS_DC); float* DN = (float*)(ws + WS_DN); float* SC = (float*)(ws + WS_SC); float* MS = (float*)(ws + WS_MS);
            {
                pg8::Gemm g{XN, (const bf16*)(ws + WS_WAI) + (size_t)e * AB_NP * DM, M, AB_NP, DM}; pg8::StaticOrder S; S.init(M, AB_NP, G, bid);
                pg8::EpiAB E{BIG, AB_NP, GATES, 14};
                pg8::gemm_phase<pg8::EpiAB, pg8::StaticOrder, true, true>(lds, g, S, E); TS(3);
#ifdef GEMM_TWICE
                pg8::gemm_phase<pg8::EpiAB, pg8::StaticOrder, true, true>(lds, g, S, E);
#endif
            }
            GRID_SYNC();
            const float* gate_b = args.in[6] + e * 16;
#ifndef SKIP_NA
            na_phase(lds, BIG, args.in[7] + (size_t)e * 8 * 465, MIX, bid, G, opaque_tid()); TS(6);
#ifdef NA_TWICE
            na_phase(lds, BIG, args.in[7] + (size_t)e * 8 * 465, MIX, bid, G, opaque_tid());
#endif
#else
            { const int t_ = opaque_tid(); for (int i = bid * NT + t_; i < M * 64; i += G * NT) { const int m_ = i >> 6, c_ = (i & 63) * 8; *(v4u*)(MIX + (size_t)m_ * DM + c_) = (v4u){0u, 0u, 0u, 0u}; } }
#endif
#ifndef SKIP_M
#ifndef ONLY_M3
            m1_phase(lds, BIG, GATES, gate_b, DC, DN, SC, bid, G, opaque_tid()); TS(7);
#ifdef M1_TWICE
            m1_phase(lds, BIG, GATES, gate_b, DC, DN, SC, bid, G, opaque_tid());
#endif
            GRID_SYNC();
            m2_phase(DC, DN, SC, MS, bid, G, opaque_tid()); TS(8);
#else
            { const int t_ = opaque_tid(); for (size_t i = (size_t)bid * NT + t_; i < (size_t)4096 * 2048; i += (size_t)G * NT) *(v4u*)(DC + i * 8) = (v4u){0u, 0u, 0u, 0u};
              for (int i = bid * NT + t_; i < 4096 * 128; i += G * NT) DN[i] = 0.f; for (int i = bid * NT + t_; i < 4096; i += G * NT) MS[i] = 0.f; }
#endif
            GRID_SYNC();
#ifndef M3_LITE
            m3_phase(lds, BIG, GATES, gate_b, DC, DN, MS, args.in[8] + e * 512, MIX, bid, G, opaque_tid()); TS(9);
#ifdef M3_TWICE
            m3_phase(lds, BIG, GATES, gate_b, DC, DN, MS, args.in[8] + e * 512, MIX, bid, G, opaque_tid());
#endif
#else
            { const int t_ = opaque_tid(); for (int i = bid * NT + t_; i < M * 64; i += G * NT) { const int m_ = i >> 6, c_ = 512 + (i & 63) * 8;
                float a0 = 0.f, a1 = 0.f, a2 = 0.f, a3 = 0.f, a4 = 0.f, a5 = 0.f, a6 = 0.f, a7 = 0.f;
                for (int k = 0; k < 4; ++k) { const v4u r = *(const v4u*)(DC + ((size_t)i + (size_t)k * M * 64) * 8);
                    a0 += bflo(r.x); a1 += bfhi(r.x); a2 += bflo(r.y); a3 += bfhi(r.y); a4 += bflo(r.z); a5 += bfhi(r.z); a6 += bflo(r.w); a7 += bfhi(r.w); }
                const float e_ = MS[i & 4095] * 0.01f + DN[i & (4096 * 128 - 1)] * 0.01f;
                v4u o; o.x = pk2(a0 * 0.05f + e_, a1 * 0.05f); o.y = pk2(a2 * 0.05f, a3 * 0.05f); o.z = pk2(a4 * 0.05f, a5 * 0.05f); o.w = pk2(a6 * 0.05f, a7 * 0.05f);
                *(v4u*)(MIX + (size_t)m_ * DM + c_) = o; } }
#endif
#else
            { const int t_ = opaque_tid(); for (int i = bid * NT + t_; i < M * 64; i += G * NT) { const int m_ = i >> 6, c_ = 512 + (i & 63) * 8; *(v4u*)(MIX + (size_t)m_ * DM + c_) = (v4u){0u, 0u, 0u, 0u}; } }
#endif
            __syncthreads();
            A2 = MIX; B2 = (const bf16*)(ws + WS_WAO) + (size_t)e * DM * DM; K2 = DM; scale2 = 1.0f;
            GRID_SYNC();
        } else {
            const int o = layer >> 1;
            {
                pg8::Gemm g{XN, (const bf16*)(ws + WS_WSI) + (size_t)o * SC_N * DM, M, SC_N, DM}; pg8::StaticOrder S; S.init(M, SC_N, G, bid);
                pg8::EpiConvIn E{BIG, BIG + (size_t)M * DM};
                pg8::gemm_phase<pg8::EpiConvIn, pg8::StaticOrder, true, true>(lds, g, S, E); TS(4);
#ifdef GEMM_TWICE
                pg8::gemm_phase<pg8::EpiConvIn, pg8::StaticOrder, true, true>(lds, g, S, E);
#endif
            }
            GRID_SYNC();
            conv_phase(BIG, BIG + (size_t)M * DM, args.in[11] + (size_t)o * 3 * DM, args.in[12] + (size_t)o * DM, MIX, bid, G, opaque_tid()); TS(10);
            A2 = MIX; B2 = (const bf16*)(ws + WS_WSO) + (size_t)o * DM * DM; K2 = DM; scale2 = 1.0f;
            GRID_SYNC();
        }
        {
            pg8::Gemm g{A2, B2, M, DM, K2}; pg8::StaticOrder S; S.init(M, DM, G, bid);
#ifdef GEMM_TWICE
            { pg8::EpiResid E0{Y, DM, 1.0f, 0.0f}; pg8::gemm_phase<pg8::EpiResid, pg8::StaticOrder, true, true>(lds, g, S, E0); }
#endif
            pg8::EpiResid E{Y, DM, DN_ALPHA, scale2};
            pg8::gemm_phase<pg8::EpiResid, pg8::StaticOrder, true, true>(lds, g, S, E); TS(2);
        }
        GRID_SYNC();
        {
            const int tid = opaque_tid(), lane = tid & 63, wave = tid >> 6;
            ln_phase(Y, XN, args.in[1] + (size_t)(layer * 3 + sub) * DM, args.in[2] + (size_t)(layer * 3 + sub) * DM, bid * NWAVES + wave, G * NWAVES, lane);
        }
        TS(5);
        GRID_SYNC();
    }
#ifdef TMASK_A
    {
        const int t_ = opaque_tid(); float* Y = args.out;
        if (bid == 0) { if (t_ == 0) Y[0] = accA * TSCALE_A; const float add = accB * TSCALE_B; for (int i = t_; i < (1 << 20); i += NT) Y[1024 + i] += add; }
    }
#endif
}

extern "C" void kernel_launch(void* const* d_in, const int* in_sizes, int n_in, void* d_out, int out_size, void* d_ws, size_t ws_size, hipStream_t stream) {
    static int grid = 0;
    if (grid == 0) {
        if (n_in != 14 || out_size != M * DM || ws_size < WS_END) { fprintf(stderr, "kernel_launch: unexpected problem (n_in %d out %d ws %zu need %zu)\n", n_in, out_size, ws_size, (size_t)WS_END); grid = -1; return; }
        int dev = 0, cus = 0, per_cu = 0;
        hipGetDevice(&dev); hipDeviceGetAttribute(&cus, hipDeviceAttributeMultiprocessorCount, dev);
        if (hipFuncSetAttribute((const void*)fwd_megakernel, hipFuncAttributeMaxDynamicSharedMemorySize, LDS_BYTES) != hipSuccess) { fprintf(stderr, "kernel_launch: hipFuncSetAttribute failed\n"); grid = -1; return; }
        if (hipOccupancyMaxActiveBlocksPerMultiprocessor(&per_cu, (const void*)fwd_megakernel, NT, LDS_BYTES) != hipSuccess || per_cu < 1) { fprintf(stderr, "kernel_launch: occupancy query gave %d\n", per_cu); per_cu = 1; }
        (void)hipGetLastError();
        grid = cus;
    }
    if (grid < 0) return;
    Args a{};
    for (int i = 0; i < 14; ++i) a.in[i] = (const float*)d_in[i];
    a.out = (float*)d_out; a.ws = (unsigned char*)d_ws;
    void* kargs[] = {&a};
    hipError_t e = hipLaunchCooperativeKernel((const void*)fwd_megakernel, dim3(grid), dim3(NT), kargs, LDS_BYTES, stream);
    if (e != hipSuccess) fprintf(stderr, "cooperative launch failed: %s (grid %d)\n", hipGetErrorString(e), grid);
}
```
